# Optimizing an MI355X kernel written in HIP

```python
import jax, jax.numpy as jnp
from jax import lax
import numpy as np

D_MODEL = 1024
BATCH = 16
SEQ = 256
DEPTH = 4
DEC_BATCH = 4
DEC_SEQ = 1024
PAST_LEN = 256

GRID_W = 64
HEAD_DIM = 64
WIDTH_A = D_MODEL // 2
N_HEADS_A = WIDTH_A // HEAD_DIM
WIDTH_B = D_MODEL // 4
N_GROUPS_B = 4
GROUP_B = WIDTH_B // N_GROUPS_B
WIDTH_C = D_MODEL // 4
N_GROUPS_C = 4
GROUP_C = WIDTH_C // N_GROUPS_C
CHUNK = 128
MIX_WIDTH = WIDTH_A + WIDTH_B + WIDTH_C
PROJ_WIDTH = 3 * WIDTH_A + WIDTH_B + 2 * WIDTH_C
WIN_ROWS_MAX = 8
WIN_COLS = 16
D_FF = ((8 * D_MODEL // 3 + 127) // 128) * 128
N_SUB = 3
EPS = 1e-6
NEG = -1e30

kernel_name = 'hybrid_natten_fnet_gmlp_diffusion_step'


def rmsnorm(x, g):
    xf = x.astype(jnp.float32)
    y = xf * lax.rsqrt(jnp.mean(xf * xf, axis=-1, keepdims=True) + EPS)
    return (y * g.astype(jnp.float32)).astype(x.dtype)


def modulate(x, g, shift, scale):
    return rmsnorm(x, g) * (1 + scale) + shift


def swiglu(h, w_in, w_out):
    gate, up = jnp.split(h @ w_in, 2, axis=-1)
    return (jax.nn.silu(gate) * up) @ w_out


def context_attention(q, k, v):
    B, S, H, Dh = q.shape
    s = jnp.einsum('bqhd,bkhd->bhqk', q, k).astype(jnp.float32) * (Dh ** -0.5)
    p = jax.nn.softmax(s, axis=-1).astype(v.dtype)
    return jnp.einsum('bhqk,bkhd->bqhd', p, v).reshape(B, S, H * Dh)


def neighbourhood_attention(q, k, v, ck, cv, rpb):
    B, N, H, Dh = q.shape
    rows = N // GRID_W
    wr = min(WIN_ROWS_MAX, rows)
    r = np.arange(rows)
    row_start = np.clip(r - wr // 2, 0, rows - wr)
    row_idx = row_start[:, None] + np.arange(wr)[None, :]
    j = np.arange(GRID_W)
    col_start = np.clip(j - WIN_COLS // 2, 0, GRID_W - WIN_COLS)
    col_mask = (j[None, :] >= col_start[:, None]) & (j[None, :] < col_start[:, None] + WIN_COLS)
    row_off = row_idx - r[:, None] + WIN_ROWS_MAX - 1
    col_off = np.clip(j[None, :] - j[:, None] + WIN_COLS - 1, 0, 2 * WIN_COLS - 2)
    bias = rpb[:, row_off[:, None, :, None], col_off[None, :, None, :]]

    qg = q.reshape(B, rows, GRID_W, H, Dh)
    kg = k.reshape(B, rows, GRID_W, H, Dh)[:, row_idx]
    vg = v.reshape(B, rows, GRID_W, H, Dh)[:, row_idx]
    scale = Dh ** -0.5
    s_loc = jnp.einsum('brqhd,brakhd->bhrqak', qg, kg).astype(jnp.float32) * scale + bias.astype(jnp.float32)[None]
    s_loc = jnp.where(col_mask[None, None, None, :, None, :], s_loc, NEG)
    s_ctx = jnp.einsum('brqhd,bchd->bhrqc', qg, ck).astype(jnp.float32) * scale
    L = wr * GRID_W
    s = jnp.concatenate([s_loc.reshape(B, H, rows, GRID_W, L), s_ctx], axis=-1)
    p = jax.nn.softmax(s, axis=-1).astype(v.dtype)
    p_loc = p[..., :L].reshape(B, H, rows, GRID_W, wr, GRID_W)
    p_ctx = p[..., L:]
    o = jnp.einsum('bhrqak,brakhd->brqhd', p_loc, vg) + jnp.einsum('bhrqc,bchd->brqhd', p_ctx, cv)
    return o.reshape(B, N, H * Dh)


def fourier_mix(f):
    B, N, _ = f.shape
    fg = f.reshape(B, N, N_GROUPS_B, GROUP_B).astype(jnp.float32)
    out = jnp.fft.fftn(fg, axes=(1, 3), norm='ortho').real
    return out.reshape(B, N, WIDTH_B).astype(f.dtype)


def gmlp_mix(z, gn, ws, gb):
    B, N, _ = z.shape
    u, v = jnp.split(jax.nn.gelu(z), 2, axis=-1)
    shp = (B, N // CHUNK, CHUNK, N_GROUPS_C, GROUP_C)
    u = u.reshape(shp)
    vf = v.reshape(shp).astype(jnp.float32)
    mu = jnp.mean(vf, axis=-1, keepdims=True)
    var = jnp.mean(jnp.square(vf - mu), axis=-1, keepdims=True)
    vn = ((vf - mu) * lax.rsqrt(var + EPS) * gn.astype(jnp.float32)).astype(z.dtype)
    sp = jnp.einsum('gpq,bnqgc->bnpgc', ws, vn) + gb.T[:, :, None]
    return (u * sp).reshape(B, N, WIDTH_C)


def trunk_layer(x, mod, npre, npost, fw_in, fw_out, w_in, w_out, gn, ws, gb, attn_fn):
    B, N, _ = x.shape
    h = modulate(x, npre[0], mod[:, :, 0], mod[:, :, 1])
    x = x + 0.5 * mod[:, :, 2] * rmsnorm(swiglu(h, fw_in[0], fw_out[0]), npost[0])

    h = modulate(x, npre[1], mod[:, :, 3], mod[:, :, 4])
    z = h @ w_in
    q, k, v, f, g = jnp.split(z, [WIDTH_A, 2 * WIDTH_A, 3 * WIDTH_A, 3 * WIDTH_A + WIDTH_B], axis=-1)
    q = q.reshape(B, N, N_HEADS_A, HEAD_DIM)
    k = k.reshape(B, N, N_HEADS_A, HEAD_DIM)
    v = v.reshape(B, N, N_HEADS_A, HEAD_DIM)
    o = jnp.concatenate([attn_fn(q, k, v), fourier_mix(f), gmlp_mix(g, gn, ws, gb)], axis=-1)
    x = x + mod[:, :, 5] * rmsnorm(o @ w_out, npost[1])

    h = modulate(x, npre[2], mod[:, :, 6], mod[:, :, 7])
    x = x + 0.5 * mod[:, :, 8] * rmsnorm(swiglu(h, fw_in[1], fw_out[1]), npost[2])
    return x, k, v


def setup_inputs(seed: int = 0) -> dict:
    key = jax.random.key(seed)
    ks = jax.random.split(key, 20)
    nrm = jax.random.normal
    f32 = jnp.float32
    return {
        'x_prompt': nrm(ks[0], (BATCH, SEQ, D_MODEL), f32),
        'x_sample': nrm(ks[1], (DEC_BATCH, DEC_SEQ, D_MODEL), f32),
        'cache_k': nrm(ks[2], (DEC_BATCH, DEPTH, PAST_LEN, N_HEADS_A, HEAD_DIM), f32),
        'cache_v': nrm(ks[3], (DEC_BATCH, DEPTH, PAST_LEN, N_HEADS_A, HEAD_DIM), f32),
        'c': nrm(ks[4], (DEC_BATCH, D_MODEL), f32),
        'c_ctx': nrm(ks[5], (D_MODEL,), f32),
        'ada_w': nrm(ks[6], (DEPTH, D_MODEL, 3 * N_SUB * D_MODEL), f32) * (0.5 * D_MODEL ** -0.5),
        'ada_b': nrm(ks[7], (DEPTH, 3 * N_SUB * D_MODEL), f32) * 0.02,
        'norm_pre': 1.0 + 0.01 * nrm(ks[8], (DEPTH, N_SUB, D_MODEL), f32),
        'norm_post': 1.0 + 0.01 * nrm(ks[9], (DEPTH, N_SUB, D_MODEL), f32),
        'ffn_w_in': nrm(ks[10], (DEPTH, 2, D_MODEL, 2 * D_FF), f32) * D_MODEL ** -0.5,
        'ffn_w_out': nrm(ks[11], (DEPTH, 2, D_FF, D_MODEL), f32) * D_FF ** -0.5,
        'w_in': nrm(ks[12], (DEPTH, D_MODEL, PROJ_WIDTH), f32) * D_MODEL ** -0.5,
        'w_out': nrm(ks[13], (DEPTH, MIX_WIDTH, D_MODEL), f32) * MIX_WIDTH ** -0.5,
        'rpb': nrm(ks[14], (DEPTH, N_HEADS_A, 2 * WIN_ROWS_MAX - 1, 2 * WIN_COLS - 1), f32) * 0.1,
        'gmlp_norm': 1.0 + 0.01 * nrm(ks[15], (DEPTH, N_GROUPS_C, GROUP_C), f32),
        'gmlp_w': nrm(ks[16], (DEPTH, N_GROUPS_C, CHUNK, CHUNK), f32) * CHUNK ** -0.5,
        'gmlp_b': 1.0 + 0.01 * nrm(ks[17], (DEPTH, N_GROUPS_C, CHUNK), f32),
    }


def reference(x_prompt, x_sample, cache_k, cache_v, c, c_ctx, ada_w, ada_b, norm_pre, norm_post,
              ffn_w_in, ffn_w_out, w_in, w_out, rpb, gmlp_norm, gmlp_w, gmlp_b):
    xp = x_prompt
    xs = x_sample
    new_ks = []
    new_vs = []
    for l in range(DEPTH):
        mod_ctx = (jax.nn.silu(c_ctx) @ ada_w[l] + ada_b[l]).reshape(1, 1, 3 * N_SUB, D_MODEL)
        mod_lat = (jax.nn.silu(c) @ ada_w[l] + ada_b[l]).reshape(-1, 1, 3 * N_SUB, D_MODEL)
        xp, k_l, v_l = trunk_layer(xp, mod_ctx, norm_pre[l], norm_post[l], ffn_w_in[l], ffn_w_out[l],
                                   w_in[l], w_out[l], gmlp_norm[l], gmlp_w[l], gmlp_b[l],
                                   context_attention)
        new_ks.append(k_l)
        new_vs.append(v_l)
        ck = cache_k[:, l]
        cv = cache_v[:, l]
        rp = rpb[l]
        xs, _, _ = trunk_layer(xs, mod_lat, norm_pre[l], norm_post[l], ffn_w_in[l], ffn_w_out[l],
                               w_in[l], w_out[l], gmlp_norm[l], gmlp_w[l], gmlp_b[l],
                               lambda q, k, v: neighbourhood_attention(q, k, v, ck, cv, rp))
    new_k = jnp.stack(new_ks, axis=1)
    new_v = jnp.stack(new_vs, axis=1)
    return (xp, xs, new_k, new_v)
```

```cpp
#include <hip/hip_runtime.h>
#include <hip/hip_cooperative_groups.h>
#include <cstdio>
#include <cstdint>
namespace cg = cooperative_groups;

#define LAS __attribute__((address_space(3)))
typedef unsigned short bf16_t;
typedef short bf16x8 __attribute__((ext_vector_type(8)));
typedef float f32x4 __attribute__((ext_vector_type(4)));
typedef unsigned u32x4 __attribute__((ext_vector_type(4)));
typedef unsigned u32x2 __attribute__((ext_vector_type(2)));

constexpr int DM = 1024, MTOK = 8192, MPR = 4096, FF = 2816, NFI = 2 * FF, NMI = 2560, NLAYER = 4;
constexpr int NWAVES = 8, NTHR = 512;
constexpr int LDS_BYTES = 147456;
constexpr float EPS = 1e-6f;

constexpr size_t MiB = 1u << 20;
constexpr size_t WS_CTL = 0, CTL_BYTES = 65536;
constexpr size_t WS_MOD = 1 * MiB;
constexpr size_t WS_DFTS = 2 * MiB;
constexpr size_t WS_DFTP = 6 * MiB;
constexpr size_t WS_CK = 7 * MiB;
constexpr size_t WS_CVT = 11 * MiB;
constexpr size_t WS_GW = 15 * MiB;
constexpr size_t WS_H = 16 * MiB;
constexpr size_t WS_Q = 32 * MiB;
constexpr size_t WS_K = 40 * MiB;
constexpr size_t WS_VT = 48 * MiB;
constexpr size_t WS_TT = 56 * MiB;
constexpr size_t WS_G = 64 * MiB;
constexpr size_t WS_O = 72 * MiB;
constexpr size_t WS_A2 = 88 * MiB;
constexpr size_t WS_Y = 136 * MiB;
constexpr size_t WS_W = 200 * MiB;
constexpr size_t W_FWI = 0, SZ_FWI = (size_t)NFI * DM * 2;
constexpr size_t W_FWO = 2 * SZ_FWI, SZ_FWO = (size_t)DM * FF * 2;
constexpr size_t W_WIN = W_FWO + 2 * SZ_FWO, SZ_WIN = (size_t)NMI * DM * 2;
constexpr size_t W_WOUT = W_WIN + SZ_WIN, SZ_WOUT = (size_t)DM * DM * 2;
constexpr size_t W_LAYER = W_WOUT + SZ_WOUT;
constexpr size_t WS_END = WS_W + NLAYER * W_LAYER;

struct Params {
    const float *x_prompt, *x_sample, *cache_k, *cache_v, *c, *c_ctx, *ada_w, *ada_b, *norm_pre, *norm_post, *ffn_w_in, *ffn_w_out, *w_in, *w_out, *rpb, *gmlp_norm, *gmlp_w, *gmlp_b;
    float* out; unsigned char* ws;
};

__device__ __forceinline__ unsigned cvt_pk_bf16(float lo, float hi) { unsigned r; asm volatile("v_cvt_pk_bf16_f32 %0, %1, %2" : "=v"(r) : "v"(lo), "v"(hi)); return r; }
__device__ __forceinline__ float wave_sum(float v) {
#pragma unroll
    for (int o = 1; o < 64; o <<= 1) v += __shfl_xor(v, o);
    return v;
}
#define LDS_WAIT() asm volatile("s_waitcnt lgkmcnt(0)" ::: "memory")
__device__ __forceinline__ int opaque_bx() { int b = blockIdx.x; asm volatile("" : "+s"(b)); return b; }
__device__ __forceinline__ int opaque_tid() { int t = threadIdx.x; asm volatile("" : "+v"(t)); return t; }

namespace pg8 {
constexpr int BM = 256, BK = 64, HALF = 128, HTB = HALF * BK * 2, STAGE_BYTES = 8 * HTB, NXCD = 8, WGM = 8;
__host__ __device__ __forceinline__ int lds_byte(int r, int c) { const int st = (r >> 4) * 2 + (c >> 5), rr = r & 15, cc = c & 31, ob = rr * 64 + cc * 2; return st * 1024 + (ob ^ (((ob >> 9) & 1) << 5)); }
__host__ __device__ __forceinline__ void stage_rc(int b, int& R, int& C) { const int st = b / 1024, sb = b % 1024, swz = sb ^ (((sb >> 9) & 1) << 5); R = (st >> 1) * 16 + swz / 64; C = (st & 1) * 32 + (swz % 64) / 2; }
__host__ __device__ __forceinline__ int perm32(int rho) { const int n = rho >> 4, i = rho & 15; return 8 * (i >> 2) + 4 * n + (i & 3); }

struct Unit { int pm, pn, ks; };
struct Gemm { const bf16_t* A; const bf16_t* Bt; };

struct StaticOrder {
    int nM, nN, nwg, G, c, nMr, gap_at, gap;
    __device__ void init(int nM_, int nN_, int ksplit, int G_, int c_, int gap_at_ = 1 << 20, int gap_ = 0) { nMr = nM_; nM = nM_ * ksplit; nN = nN_; nwg = nM * nN; G = G_; c = c_; gap_at = gap_at_; gap = gap_; }
    __device__ bool next(int i, Unit& u) const {
        const long L = (long)i * G + c; if (L >= nwg) return false;
        int wgid = (int)L; { const int q = nwg / NXCD, r = nwg % NXCD, xcd = wgid % NXCD, off = wgid / NXCD; wgid = (xcd < r ? xcd * (q + 1) : r * (q + 1) + (xcd - r) * q) + off; }
        const int nig = WGM * nN, gid = wgid / nig, fm = gid * WGM, gsz = (nM - fm) < WGM ? (nM - fm) : WGM;
        const int pmv = fm + ((wgid % nig) % gsz); u.pn = (wgid % nig) / gsz; if (u.pn >= gap_at) u.pn += gap; u.ks = pmv / nMr; u.pm = pmv % nMr; return true;
    }
};
struct SubsetOrder {
    int c0, nM, n, c, pn0;
    __device__ bool next(int i, Unit& u) const { const int j = c - c0; if (i != 0 || j < 0 || j >= n) return false; u.pm = j % nM; u.pn = pn0 + j / nM; u.ks = 0; return true; }
};

template <int LDA, int LDB, int KLOOP, class Epi, class Sched, bool ALIGN_EPI = true, bool SP2 = true>
__device__ __forceinline__ void gemm_phase(LAS unsigned char* lds, const Gemm g, const Sched& S, const Epi& E) {
    const int tid = opaque_tid(), wid = __builtin_amdgcn_readfirstlane(tid >> 6), lane = tid & 63, wr = wid >> 2, wc = wid & 3, fr = lane & 15, fq = lane >> 4;
    constexpr int nt = KLOOP / BK;
    unsigned voffA[2], voffB[2];
#pragma unroll
    for (int i = 0; i < 2; ++i) { int R, C; stage_rc(tid * 16 + i * 8192, R, C); const int Rb = Epi::PERM ? ((R & ~31) + perm32(R & 31)) : R;
        voffA[i] = (unsigned)(R * LDA + C) * 2u; voffB[i] = (unsigned)(Rb * LDB + C) * 2u; }
    constexpr size_t kstep = (size_t)(BK * 2);
    constexpr size_t hstepA = (size_t)HALF * LDA * 2, hstepB = (size_t)HALF * LDB * 2;
    constexpr size_t tstepA = 2 * hstepA, tstepB = 2 * hstepB;
    const unsigned ldsw = (unsigned)wid * 1024u;
    const int aoff = lds_byte(wr * 64 + fr, fq * 8), boff = lds_byte(wc * 32 + fr, fq * 8);
#define PG8_SA(b, h) (((b) * 2 + (h)) * HTB)
#define PG8_SB(b, h) ((4 + (b) * 2 + (h)) * HTB)
#define PG8_STAGE(bufoff, gbase, voff) do { _Pragma("unroll") for (int _i = 0; _i < 2; ++_i) \
        __builtin_amdgcn_global_load_lds((const unsigned*)((const char*)(gbase) + (voff)[_i]), (LAS unsigned*)(lds + (bufoff) + ldsw + _i * 8192), 16, 0, 0); } while (0)
#define PG8_LDA(dst, b, h) do { _Pragma("unroll") for (int m = 0; m < 4; ++m) _Pragma("unroll") for (int k = 0; k < 2; ++k) dst[m][k] = *(const LAS bf16x8*)(lds + PG8_SA(b, h) + aoff + m * 2048 + k * 1024); } while (0)
#define PG8_LDB(dst, b, h) do { _Pragma("unroll") for (int n = 0; n < 2; ++n) _Pragma("unroll") for (int k = 0; k < 2; ++k) dst[n][k] = *(const LAS bf16x8*)(lds + PG8_SB(b, h) + boff + n * 2048 + k * 1024); } while (0)
#define PG8_MMA(ai, bj, At, Bt) do { __builtin_amdgcn_s_setprio(1); _Pragma("unroll") for (int m = 0; m < 4; ++m) _Pragma("unroll") for (int n = 0; n < 2; ++n) _Pragma("unroll") for (int k = 0; k < 2; ++k) \
        acc[ai][bj][m][n] = __builtin_amdgcn_mfma_f32_16x16x32_bf16(Bt[n][k], At[m][k], acc[ai][bj][m][n], 0, 0, 0); __builtin_amdgcn_s_setprio(0); } while (0)
#define PG8_WAIT_V(n) asm volatile("s_waitcnt vmcnt(" #n ")" ::: "memory")
#define PG8_WAIT_L(n) asm volatile("s_waitcnt lgkmcnt(" #n ")" ::: "memory")
#define PG8_BAR __builtin_amdgcn_s_barrier()
#define PG8_SCHED __builtin_amdgcn_sched_barrier(0)
    Unit cur, nxt; int ui = 0;
    if (!S.next(0, cur)) return;
    f32x4 acc[2][2][4][2];
#pragma unroll
    for (int a = 0; a < 2; ++a)
#pragma unroll
        for (int b = 0; b < 2; ++b)
#pragma unroll
            for (int m = 0; m < 4; ++m)
#pragma unroll
                for (int n = 0; n < 2; ++n) acc[a][b][m][n] = (f32x4){0.f, 0.f, 0.f, 0.f};
    bf16x8 At[4][2], B0[2][2], B1[2][2];
    constexpr size_t ksoff = (size_t)KLOOP * 2;
    const char* cA = (const char*)g.A + (size_t)cur.pm * tstepA + (size_t)cur.ks * ksoff; const char* cB = (const char*)g.Bt + (size_t)cur.pn * tstepB + (size_t)cur.ks * ksoff;
    if constexpr (SP2) {
        PG8_STAGE(PG8_SB(0, 0), cB, voffB); PG8_STAGE(PG8_SB(0, 1), cB + hstepB, voffB); PG8_STAGE(PG8_SA(0, 0), cA, voffA); PG8_STAGE(PG8_SA(0, 1), cA + hstepA, voffA);
        if (wr == 1) PG8_BAR;
        PG8_WAIT_V(2); PG8_BAR;
        PG8_STAGE(PG8_SB(1, 0), cB + kstep, voffB); PG8_STAGE(PG8_SA(1, 0), cA + kstep, voffA); PG8_STAGE(PG8_SB(1, 1), cB + hstepB + kstep, voffB);
        PG8_WAIT_V(6); PG8_BAR;
    }
    for (;;) {
        const bool has_next = S.next(ui + 1, nxt);
        const char* nA = has_next ? (const char*)g.A + (size_t)nxt.pm * tstepA + (size_t)nxt.ks * ksoff : cA; const char* nB = has_next ? (const char*)g.Bt + (size_t)nxt.pn * tstepB + (size_t)nxt.ks * ksoff : cB;
        for (int t = 0; t < nt; t += 2) {
            const bool last = (t == nt - 2);
            const char* a1 = cA + (size_t)(t + 1) * kstep;
            const char* a2 = last ? nA : cA + (size_t)(t + 2) * kstep; const char* b2 = last ? nB : cB + (size_t)(t + 2) * kstep;
            const char* a3 = a2 + kstep; const char* b3 = b2 + kstep;
            PG8_LDB(B0, 0, 0); PG8_LDB(B1, 0, 1); PG8_SCHED; PG8_LDA(At, 0, 0); PG8_STAGE(PG8_SA(1, 1), a1 + hstepA, voffA);
            PG8_WAIT_V(8); PG8_WAIT_L(0); PG8_BAR; PG8_MMA(0, 0, At, B0); PG8_MMA(0, 1, At, B1); PG8_BAR; PG8_SCHED;
            PG8_LDA(At, 0, 1); PG8_STAGE(PG8_SB(0, 0), b2, voffB); PG8_STAGE(PG8_SB(0, 1), b2 + hstepB, voffB); PG8_STAGE(PG8_SA(0, 0), a2, voffA);
            PG8_WAIT_V(8); PG8_WAIT_L(0); PG8_BAR; PG8_MMA(1, 0, At, B0); PG8_MMA(1, 1, At, B1); PG8_BAR; PG8_SCHED;
            PG8_LDB(B0, 1, 0); PG8_LDB(B1, 1, 1); PG8_SCHED; PG8_LDA(At, 1, 0); PG8_STAGE(PG8_SA(0, 1), a2 + hstepA, voffA);
            PG8_WAIT_V(8); PG8_WAIT_L(0); PG8_BAR; PG8_MMA(0, 0, At, B0); PG8_MMA(0, 1, At, B1); PG8_BAR; PG8_SCHED;
            PG8_LDA(At, 1, 1); PG8_STAGE(PG8_SB(1, 0), b3, voffB); PG8_STAGE(PG8_SB(1, 1), b3 + hstepB, voffB); PG8_STAGE(PG8_SA(1, 0), a3, voffA);
            PG8_WAIT_V(8); PG8_WAIT_L(0); PG8_BAR; PG8_MMA(1, 0, At, B0); PG8_MMA(1, 1, At, B1); PG8_BAR; PG8_SCHED;
        }
        if constexpr (ALIGN_EPI) { if (wr == 0) PG8_BAR; }
        E(acc, cur, wr, wc, fr, fq);
        if (!has_next) break;
#pragma unroll
        for (int a = 0; a < 2; ++a)
#pragma unroll
            for (int b = 0; b < 2; ++b)
#pragma unroll
                for (int m = 0; m < 4; ++m)
#pragma unroll
                    for (int n = 0; n < 2; ++n) acc[a][b][m][n] = (f32x4){0.f, 0.f, 0.f, 0.f};
        cur = nxt; cA = nA; cB = nB; ++ui;
        if constexpr (ALIGN_EPI) { if (wr == 1) PG8_BAR; }
    }
    PG8_WAIT_V(0);
    if constexpr (!ALIGN_EPI) { if (wr == 0) PG8_BAR; }
    PG8_BAR;
#undef PG8_SA
#undef PG8_SB
#undef PG8_STAGE
#undef PG8_LDA
#undef PG8_LDB
#undef PG8_MMA
#undef PG8_WAIT_V
#undef PG8_WAIT_L
#undef PG8_BAR
#undef PG8_SCHED
}
}

__device__ __forceinline__ float silu_f(float v) { return v * __builtin_amdgcn_rcpf(1.f + __expf(-v)); }
__device__ __forceinline__ float gelu_tanh_f(float v) { const float u = 0.7978845608f * (v + 0.044715f * v * v * v); const float t = __expf(2.f * u); const float th = 1.f - 2.f * __builtin_amdgcn_rcpf(t + 1.f); return 0.5f * v * (1.f + th); }

struct EpiSwiglu {
    static constexpr bool PERM = true;
    unsigned char* ws;
    __device__ __forceinline__ void operator()(const f32x4 (&acc)[2][2][4][2], const pg8::Unit& u, int wr, int wc, int fr, int fq) const {
        bf16_t* A2 = (bf16_t*)(ws + WS_A2);
        const int row0 = u.pm * 256 + wr * 64 + fr, col0 = u.pn * 128 + wc * 32 + 8 * fq;
#pragma unroll
        for (int ai = 0; ai < 2; ++ai)
#pragma unroll
            for (int m = 0; m < 4; ++m) {
                const f32x4 g0 = acc[ai][0][m][0], g1 = acc[ai][0][m][1], u0 = acc[ai][1][m][0], u1 = acc[ai][1][m][1];
                u32x4 w;
                w.x = cvt_pk_bf16(silu_f(g0[0]) * u0[0], silu_f(g0[1]) * u0[1]); w.y = cvt_pk_bf16(silu_f(g0[2]) * u0[2], silu_f(g0[3]) * u0[3]);
                w.z = cvt_pk_bf16(silu_f(g1[0]) * u1[0], silu_f(g1[1]) * u1[1]); w.w = cvt_pk_bf16(silu_f(g1[2]) * u1[2], silu_f(g1[3]) * u1[3]);
                *(u32x4*)(A2 + (size_t)(row0 + ai * 128 + m * 16) * FF + col0) = w;
            }
    }
};
struct EpiF32 {
    static constexpr bool PERM = true;
    unsigned char* ws;
    __device__ __forceinline__ void operator()(const f32x4 (&acc)[2][2][4][2], const pg8::Unit& u, int wr, int wc, int fr, int fq) const {
        bf16_t* base = (bf16_t*)(ws + WS_Y) + (size_t)u.ks * MTOK * DM + (size_t)(u.pm * 256 + wr * 64 + fr) * DM + u.pn * 256 + wc * 32 + 8 * fq;
#pragma unroll
        for (int ai = 0; ai < 2; ++ai)
#pragma unroll
            for (int m = 0; m < 4; ++m)
#pragma unroll
                for (int bj = 0; bj < 2; ++bj) { const f32x4 v0 = acc[ai][bj][m][0], v1 = acc[ai][bj][m][1];
                    u32x4 w; w.x = cvt_pk_bf16(v0[0], v0[1]); w.y = cvt_pk_bf16(v0[2], v0[3]); w.z = cvt_pk_bf16(v1[0], v1[1]); w.w = cvt_pk_bf16(v1[2], v1[3]);
                    *(u32x4*)(base + (size_t)(ai * 128 + m * 16) * DM + bj * 128) = w; }
    }
};
struct EpiMixIn {
    static constexpr bool PERM = true;
    unsigned char* ws; float* out; int l;
    __device__ __forceinline__ void operator()(const f32x4 (&acc)[2][2][4][2], const pg8::Unit& u, int wr, int wc, int fr, int fq) const {
        bf16_t* Qb = (bf16_t*)(ws + WS_Q); bf16_t* Kb = (bf16_t*)(ws + WS_K); bf16_t* VT = (bf16_t*)(ws + WS_VT); bf16_t* TT = (bf16_t*)(ws + WS_TT); bf16_t* Gb = (bf16_t*)(ws + WS_G);
        float* newk = out + (size_t)MTOK * DM; float* newv = newk + (size_t)16 * 4 * 256 * 512;
        const int pn = u.pn;
        const bool prompt = u.pm < 16;
#pragma unroll
        for (int ai = 0; ai < 2; ++ai)
#pragma unroll
            for (int m = 0; m < 4; ++m) {
                const int row = u.pm * 256 + ai * 128 + wr * 64 + m * 16 + fr;
                const int bb = prompt ? (row >> 8) : ((row - MPR) >> 10), tt = prompt ? (row & 255) : ((row - MPR) & 1023);
#pragma unroll
                for (int bj = 0; bj < 2; ++bj) {
                    const int ct = bj * 128 + wc * 32 + 8 * fq;
                    f32x4 v0 = acc[ai][bj][m][0], v1 = acc[ai][bj][m][1];
                    if (pn < 2) {
                        v0 = v0 * 0.125f; v1 = v1 * 0.125f; u32x4 w; w.x = cvt_pk_bf16(v0[0], v0[1]); w.y = cvt_pk_bf16(v0[2], v0[3]); w.z = cvt_pk_bf16(v1[0], v1[1]); w.w = cvt_pk_bf16(v1[2], v1[3]);
                        *(u32x4*)(Qb + (size_t)row * 512 + pn * 256 + ct) = w;
                    } else if (pn < 4) {
                        const int c0 = (pn - 2) * 256 + ct;
                        u32x4 w; w.x = cvt_pk_bf16(v0[0], v0[1]); w.y = cvt_pk_bf16(v0[2], v0[3]); w.z = cvt_pk_bf16(v1[0], v1[1]); w.w = cvt_pk_bf16(v1[2], v1[3]);
                        { const int hd = c0 >> 6, dd = c0 & 63;
                          bf16_t* kd = prompt ? Kb + ((size_t)((bb * 8 + hd) * 256 + tt)) * 64 + dd : Kb + 2097152 + ((size_t)((bb * 8 + hd) * 1024 + tt)) * 64 + dd;
                          *(u32x4*)kd = w; }
                        if (prompt) { float* o = newk + ((size_t)(bb * 4 + l) * 256 + tt) * 512 + c0; *(f32x4*)o = v0; *(f32x4*)(o + 4) = v1; }
                    } else if (pn < 6) {
                        const int c0 = (pn - 4) * 256 + ct;
                        if (prompt) { float* o = newv + ((size_t)(bb * 4 + l) * 256 + tt) * 512 + c0; *(f32x4*)o = v0; *(f32x4*)(o + 4) = v1; }
                        const int hd = c0 >> 6, dd = c0 & 63;
                        bf16_t* vt = prompt ? VT + ((size_t)((bb * 8 + hd) * 8 + (tt >> 5))) * 2048 + dd * 32 + (tt & 31) : VT + 2097152 + ((size_t)((bb * 8 + hd) * 16 + (tt >> 6))) * 4096 + dd * 64 + (tt & 63);
                        const size_t vp = prompt ? 32 : 64;
#pragma unroll
                        for (int i = 0; i < 4; ++i) { vt[(size_t)i * vp] = (bf16_t)(cvt_pk_bf16(v0[i], v0[i]) & 0xffffu); vt[(size_t)(i + 4) * vp] = (bf16_t)(cvt_pk_bf16(v1[i], v1[i]) & 0xffffu); }
                    } else if (pn < 8) {
                        const int half = pn - 6;
                        bf16_t* t = prompt ? TT + ((size_t)(bb * 256 + ct) * 512 + half * 256 + tt) : TT + 2097152 + ((size_t)(bb * 256 + ct) * 2048 + half * 1024 + tt);
                        const size_t tp = prompt ? 512 : 2048;
#pragma unroll
                        for (int i = 0; i < 4; ++i) { t[(size_t)i * tp] = (bf16_t)(cvt_pk_bf16(v0[i], v0[i]) & 0xffffu); t[(size_t)(i + 4) * tp] = (bf16_t)(cvt_pk_bf16(v1[i], v1[i]) & 0xffffu); }
                    } else {
                        u32x4 w; w.x = cvt_pk_bf16(gelu_tanh_f(v0[0]), gelu_tanh_f(v0[1])); w.y = cvt_pk_bf16(gelu_tanh_f(v0[2]), gelu_tanh_f(v0[3]));
                        w.z = cvt_pk_bf16(gelu_tanh_f(v1[0]), gelu_tanh_f(v1[1])); w.w = cvt_pk_bf16(gelu_tanh_f(v1[2]), gelu_tanh_f(v1[3]));
                        *(u32x4*)(Gb + (size_t)row * 512 + (pn - 8) * 256 + ct) = w;
                    }
                }
            }
    }
};
struct EpiFourier {
    static constexpr bool PERM = true;
    unsigned char* ws; int row0, rpb_;
    __device__ __forceinline__ void operator()(const f32x4 (&acc)[2][2][4][2], const pg8::Unit& u, int wr, int wc, int fr, int fq) const {
        bf16_t* O = (bf16_t*)(ws + WS_O);
        const int rowb = row0 + u.pn * rpb_ + u.pm * 256 + wr * 64 + fr;
#pragma unroll
        for (int ai = 0; ai < 2; ++ai)
#pragma unroll
            for (int m = 0; m < 4; ++m)
#pragma unroll
                for (int bj = 0; bj < 2; ++bj) {
                    const f32x4 v0 = acc[ai][bj][m][0], v1 = acc[ai][bj][m][1];
                    u32x4 w; w.x = cvt_pk_bf16(v0[0], v0[1]); w.y = cvt_pk_bf16(v0[2], v0[3]); w.z = cvt_pk_bf16(v1[0], v1[1]); w.w = cvt_pk_bf16(v1[2], v1[3]);
                    *(u32x4*)(O + (size_t)(rowb + ai * 128 + m * 16) * DM + 512 + bj * 128 + wc * 32 + 8 * fq) = w;
                }
    }
};

__device__ __forceinline__ void transpose_item(const float* W, int ldw, int k0, int n0, bf16_t* WT, int ldt, int drow0, LAS float* scr, int lane) {
    float v[32];
    const float* src = W + (size_t)(k0 + (lane >> 5)) * ldw + n0 + (lane & 31);
#pragma unroll
    for (int i = 0; i < 32; ++i) v[i] = __builtin_nontemporal_load(src + (size_t)(2 * i) * ldw);
#pragma unroll
    for (int i = 0; i < 32; ++i) scr[(2 * i + (lane >> 5)) * 33 + (lane & 31)] = v[i];
    LDS_WAIT(); asm volatile("" ::: "memory");
    const int c = lane & 7;
#pragma unroll
    for (int j = 0; j < 4; ++j) { const int n = (lane >> 3) + 8 * j; const LAS float* s = scr + (8 * c) * 33 + n;
        u32x4 o; o.x = cvt_pk_bf16(s[0 * 33], s[1 * 33]); o.y = cvt_pk_bf16(s[2 * 33], s[3 * 33]); o.z = cvt_pk_bf16(s[4 * 33], s[5 * 33]); o.w = cvt_pk_bf16(s[6 * 33], s[7 * 33]);
        *(u32x4*)(WT + (size_t)(drow0 + n) * ldt + k0 + 8 * c) = o; }
    LDS_WAIT(); asm volatile("" ::: "memory");
}

__device__ __forceinline__ void mod_items(const Params& p, LAS unsigned char* lds, int l, int first, int stride) {
    const int tid = opaque_tid(), lane = tid & 63, wave = __builtin_amdgcn_readfirstlane(tid >> 6);
    if (first >= 64) return;
    LAS float* sc = (LAS float*)lds;
    LAS float* red = (LAS float*)(lds + 20480);
    {   float cv[10];
#pragma unroll
        for (int j = 0; j < 10; ++j) { const int i = tid + j * NTHR, mi = i >> 10, k = i & 1023; cv[j] = mi == 0 ? p.c_ctx[k] : p.c[(mi - 1) * 1024 + k]; }
#pragma unroll
        for (int j = 0; j < 10; ++j) sc[tid + j * NTHR] = cv[j] * __builtin_amdgcn_rcpf(1.f + __expf(-cv[j]));
    }
    __syncthreads();
    float* part = (float*)(p.ws + WS_Y);
    for (int item = first; item < 64; item += stride) {
        const int cs = item >> 2, kq = item & 3, n0 = cs * 576, kbase = kq * 256 + wave * 32;
        const int ln = lane < 36 ? lane : 35;
        const float* wp = p.ada_w + ((size_t)l * 1024 + kbase) * 9216 + n0 + ln * 4;
        float sv[5];
#pragma unroll
        for (int mi = 0; mi < 5; ++mi) sv[mi] = sc[mi * 1024 + kbase + (lane & 31)];
        f32x4 acc[4][5];
#pragma unroll
        for (int st = 0; st < 4; ++st)
#pragma unroll
            for (int mi = 0; mi < 5; ++mi) acc[st][mi] = (f32x4){0.f, 0.f, 0.f, 0.f};
#pragma unroll 1
        for (int rb = 0; rb < 32; rb += 4) {
            f32x4 w[4][4];
#pragma unroll
            for (int r = 0; r < 4; ++r)
#pragma unroll
                for (int st = 0; st < 4; ++st) w[r][st] = __builtin_nontemporal_load((const f32x4*)(wp + (size_t)(rb + r) * 9216 + st * 144));
#pragma unroll
            for (int r = 0; r < 4; ++r)
#pragma unroll
                for (int mi = 0; mi < 5; ++mi) { const float sm = __builtin_bit_cast(float, __builtin_amdgcn_readlane(__builtin_bit_cast(int, sv[mi]), rb + r));
#pragma unroll
                    for (int st = 0; st < 4; ++st) acc[st][mi] += w[r][st] * sm; }
        }
        if (lane < 36) {
#pragma unroll
            for (int st = 0; st < 4; ++st)
#pragma unroll
                for (int mi = 0; mi < 5; ++mi) *(LAS f32x4*)(red + (wave * 5 + mi) * 576 + st * 144 + lane * 4) = acc[st][mi];
        }
        __syncthreads();
        for (int o = tid; o < 2880; o += NTHR) { const int mi = o / 576, cc = o % 576; float sum = 0.f;
#pragma unroll
            for (int w = 0; w < 8; ++w) sum += red[(w * 5 + mi) * 576 + cc];
            const int n = n0 + cc; part[(size_t)kq * (NLAYER * 5 * 9216) + (size_t)(l * 5 + mi) * 9216 + n] = sum; }
        __syncthreads();
    }
}

__device__ __forceinline__ void fwi0_items(const Params& p, LAS unsigned char* lds, int l, int sfx, int first, int stride) {
    const int tid = opaque_tid(), lane = tid & 63, wave = __builtin_amdgcn_readfirstlane(tid >> 6);
    LAS float* scr = (LAS float*)(lds + wave * 8704);
    unsigned char* wl = p.ws + WS_W + (size_t)l * W_LAYER;
    constexpr int NIT = 16 * 176 + 44 * 32;
    const int f0 = first + wave; if (f0 >= NIT) return;
    const int nmine = (NIT - 1 - f0) / stride + 1;
#define FW_DEC(j_, S_, LDW_, D_, LDT_) do { int r_ = f0 + (j_) * stride; \
        if (r_ < 16 * 176) { const int kb_ = r_ / 176, n0_ = (r_ % 176) * 32; \
            const int drow_ = n0_ < FF ? (n0_ >> 7) * 256 + (n0_ & 127) : ((n0_ - FF) >> 7) * 256 + 128 + ((n0_ - FF) & 127); \
            S_ = p.ffn_w_in + (size_t)(l * 2 + sfx) * 1024 * NFI + (size_t)(kb_ * 64 + (lane >> 5)) * NFI + n0_ + (lane & 31); LDW_ = NFI; \
            D_ = (bf16_t*)(wl + W_FWI + sfx * SZ_FWI) + (size_t)drow_ * 1024 + kb_ * 64; LDT_ = 1024; } \
        else { r_ -= 16 * 176; const int kb_ = r_ / 32, nb_ = r_ % 32; \
            S_ = p.ffn_w_out + (size_t)(l * 2 + sfx) * FF * 1024 + (size_t)(kb_ * 64 + (lane >> 5)) * 1024 + nb_ * 32 + (lane & 31); LDW_ = 1024; \
            D_ = (bf16_t*)(wl + W_FWO + sfx * SZ_FWO) + (size_t)(nb_ * 32) * FF + kb_ * 64; LDT_ = FF; } } while (0)
#define FW_LOAD(S_, LDW_, V) do { _Pragma("unroll") for (int i = 0; i < 32; ++i) V[i] = __builtin_nontemporal_load((S_) + (size_t)(2 * i) * (LDW_)); } while (0)
#define FW_STORE(D_, LDT_, V) do { _Pragma("unroll") for (int i = 0; i < 32; ++i) scr[(2 * i + (lane >> 5)) * 33 + (lane & 31)] = V[i]; \
        LDS_WAIT(); asm volatile("" ::: "memory"); const int c_ = lane & 7; \
        _Pragma("unroll") for (int j_ = 0; j_ < 4; ++j_) { const int n_ = (lane >> 3) + 8 * j_; const LAS float* q_ = scr + (8 * c_) * 33 + n_; \
            u32x4 o_; o_.x = cvt_pk_bf16(q_[0 * 33], q_[1 * 33]); o_.y = cvt_pk_bf16(q_[2 * 33], q_[3 * 33]); o_.z = cvt_pk_bf16(q_[4 * 33], q_[5 * 33]); o_.w = cvt_pk_bf16(q_[6 * 33], q_[7 * 33]); \
            *(u32x4*)((D_) + (size_t)n_ * (LDT_) + 8 * c_) = o_; } \
        LDS_WAIT(); asm volatile("" ::: "memory"); } while (0)
    const float* sA; bf16_t* dA; int wA_, tA_; const float* sB; bf16_t* dB; int wB_, tB_; float va[32], vb[32];
    FW_DEC(0, sA, wA_, dA, tA_); FW_LOAD(sA, wA_, va);
#pragma unroll 1
    for (int j = 0; j < nmine; j += 2) {
        FW_DEC(min(j + 1, nmine - 1), sB, wB_, dB, tB_); FW_LOAD(sB, wB_, vb);
        FW_STORE(dA, tA_, va);
        FW_DEC(min(j + 2, nmine - 1), sA, wA_, dA, tA_); FW_LOAD(sA, wA_, va);
        if (j + 1 < nmine) FW_STORE(dB, tB_, vb);
    }
#undef FW_DEC
#undef FW_LOAD
#undef FW_STORE
}

__device__ __forceinline__ void prologue(const Params& p, LAS unsigned char* lds, int G) {
    const int tid = opaque_tid(), lane = tid & 63, wave = __builtin_amdgcn_readfirstlane(tid >> 6);
    const int bx = blockIdx.x;
    unsigned char* ws = p.ws;
    mod_items(p, lds, bx >> 6, bx & 63, 64);
    LAS float* tabc = (LAS float*)(lds + 73728); LAS float* tabs = (LAS float*)(lds + 90112);
    for (int i = tid; i < 4096; i += NTHR) { const int j = ((i >> 6) * (i & 63)) & 63; tabc[i] = cospif((float)j * (1.f / 32.f)) * 0.125f; tabs[i] = sinpif((float)j * (1.f / 32.f)) * 0.125f; }
    __syncthreads();
    const int gw = bx * NWAVES + wave, NGW = G * NWAVES;
    LAS float* scr = (LAS float*)(lds + wave * 8704);
    for (int it = gw; it < NLAYER * 64 * 8; it += NGW) {
        const int l = it >> 9, r = (it >> 3) & 63, cq = it & 7;
        unsigned char* wl = ws + WS_W + (size_t)l * W_LAYER;
        const int kb = r >> 2, g = r & 3, k = kb * 64 + lane;
        const float* src = p.w_in + ((size_t)l * 1024 + k) * 2304 + 1536 + g * 64;
        f32x4 w[16];
#pragma unroll
        for (int i = 0; i < 16; ++i) w[i] = *(const f32x4*)(src + 4 * i);
        bf16_t* d1 = (bf16_t*)(wl + W_WIN) + (size_t)(1536 + g * 64) * 1024 + k; bf16_t* d2 = d1 + (size_t)256 * 1024;
        for (int cp = cq * 8; cp < cq * 8 + 8; ++cp) {
            float t1 = 0.f, t2 = 0.f;
#pragma unroll
            for (int c4 = 0; c4 < 16; ++c4) { const f32x4 tc = *(const LAS f32x4*)(tabc + cp * 64 + 4 * c4), ts = *(const LAS f32x4*)(tabs + cp * 64 + 4 * c4); const f32x4 wv = w[c4];
                t1 += (wv[0] * tc[0] + wv[1] * tc[1]) + (wv[2] * tc[2] + wv[3] * tc[3]); t2 += (wv[0] * ts[0] + wv[1] * ts[1]) + (wv[2] * ts[2] + wv[3] * ts[3]); }
            d1[(size_t)cp * 1024] = (bf16_t)(cvt_pk_bf16(t1, t1) & 0xffffu); d2[(size_t)cp * 1024] = (bf16_t)(cvt_pk_bf16(t2, t2) & 0xffffu);
        }
    }
    constexpr int I_FWI = 16 * 176, I_FWO = 44 * 32, I_QKV = 16 * 48, I_G = 16 * 16, I_WO = 16 * 32;
    constexpr int I_REST = 2 * I_FWO + I_QKV + I_G + I_WO, I_REST3 = I_QKV + I_G + I_WO, I_L0 = I_FWI + I_FWO + I_REST3, I_ALL = I_L0 + 3 * I_REST3;
#define TR_DECODE(it_, SRC, LDW, DST, LDT) do { int r_ = (it_), l_ = 0; \
        if (r_ >= I_L0) { r_ -= I_L0; l_ = 1 + r_ / I_REST3; r_ = r_ % I_REST3 + 2 * I_FWI + 2 * I_FWO; } \
        else if (r_ >= I_FWI + I_FWO) r_ += I_FWI + I_FWO; else if (r_ >= I_FWI) r_ += I_FWI; \
        unsigned char* wl_ = ws + WS_W + (size_t)l_ * W_LAYER; \
        if (r_ < 2 * I_FWI) { const int s_ = r_ / I_FWI; r_ %= I_FWI; const int kb_ = r_ / 176, n0_ = (r_ % 176) * 32; \
            const int drow_ = n0_ < FF ? (n0_ >> 7) * 256 + (n0_ & 127) : ((n0_ - FF) >> 7) * 256 + 128 + ((n0_ - FF) & 127); \
            SRC = p.ffn_w_in + (size_t)(l_ * 2 + s_) * 1024 * NFI + (size_t)(kb_ * 64) * NFI + n0_; LDW = NFI; DST = (bf16_t*)(wl_ + W_FWI + s_ * SZ_FWI) + (size_t)drow_ * 1024 + kb_ * 64; LDT = 1024; } \
        else { r_ -= 2 * I_FWI; \
          if (r_ < 2 * I_FWO) { const int s_ = r_ / I_FWO; r_ %= I_FWO; const int kb_ = r_ / 32, nb_ = r_ % 32; \
            SRC = p.ffn_w_out + (size_t)(l_ * 2 + s_) * FF * 1024 + (size_t)(kb_ * 64) * 1024 + nb_ * 32; LDW = 1024; DST = (bf16_t*)(wl_ + W_FWO + s_ * SZ_FWO) + (size_t)(nb_ * 32) * FF + kb_ * 64; LDT = FF; } \
          else { r_ -= 2 * I_FWO; \
            if (r_ < I_QKV) { const int kb_ = r_ / 48, nb_ = r_ % 48; SRC = p.w_in + (size_t)l_ * 1024 * 2304 + (size_t)(kb_ * 64) * 2304 + nb_ * 32; LDW = 2304; DST = (bf16_t*)(wl_ + W_WIN) + (size_t)(nb_ * 32) * 1024 + kb_ * 64; LDT = 1024; } \
            else { r_ -= I_QKV; \
              if (r_ < I_G) { const int kb_ = r_ / 16, nb_ = r_ % 16; SRC = p.w_in + (size_t)l_ * 1024 * 2304 + (size_t)(kb_ * 64) * 2304 + 1792 + nb_ * 32; LDW = 2304; DST = (bf16_t*)(wl_ + W_WIN) + (size_t)(2048 + nb_ * 32) * 1024 + kb_ * 64; LDT = 1024; } \
              else { r_ -= I_G; const int kb_ = r_ / 32, nb_ = r_ % 32; SRC = p.w_out + (size_t)l_ * 1024 * 1024 + (size_t)(kb_ * 64) * 1024 + nb_ * 32; LDW = 1024; DST = (bf16_t*)(wl_ + W_WOUT) + (size_t)(nb_ * 32) * 1024 + kb_ * 64; LDT = 1024; } } } } } while (0)
#define TR_LOAD(SRC, LDW, V) do { const float* s_ = (SRC) + (size_t)(lane >> 5) * (LDW) + (lane & 31); _Pragma("unroll") for (int i = 0; i < 32; ++i) V[i] = __builtin_nontemporal_load(s_ + (size_t)(2 * i) * (LDW)); } while (0)
#define TR_STORE(DST, LDT, V) do { _Pragma("unroll") for (int i = 0; i < 32; ++i) scr[(2 * i + (lane >> 5)) * 33 + (lane & 31)] = V[i]; \
        LDS_WAIT(); asm volatile("" ::: "memory"); const int c_ = lane & 7; \
        _Pragma("unroll") for (int j = 0; j < 4; ++j) { const int n_ = (lane >> 3) + 8 * j; const LAS float* q_ = scr + (8 * c_) * 33 + n_; \
            u32x4 o_; o_.x = cvt_pk_bf16(q_[0 * 33], q_[1 * 33]); o_.y = cvt_pk_bf16(q_[2 * 33], q_[3 * 33]); o_.z = cvt_pk_bf16(q_[4 * 33], q_[5 * 33]); o_.w = cvt_pk_bf16(q_[6 * 33], q_[7 * 33]); \
            *(u32x4*)((DST) + (size_t)n_ * (LDT) + 8 * c_) = o_; } \
        LDS_WAIT(); asm volatile("" ::: "memory"); } while (0)
    if (gw < I_ALL) {
        const int nmine = (I_ALL - 1 - gw) / NGW + 1;
        const float* sA; int ldwA; bf16_t* dA; int ldtA; const float* sB; int ldwB; bf16_t* dB; int ldtB;
        float va[32], vb[32];
        TR_DECODE(gw, sA, ldwA, dA, ldtA); TR_LOAD(sA, ldwA, va);
#pragma unroll 1
        for (int j = 0; j < nmine; j += 2) {
            { const int jn = min(j + 1, nmine - 1); TR_DECODE(gw + jn * NGW, sB, ldwB, dB, ldtB); TR_LOAD(sB, ldwB, vb); }
            TR_STORE(dA, ldtA, va);
            { const int jn = min(j + 2, nmine - 1); TR_DECODE(gw + jn * NGW, sA, ldwA, dA, ldtA); TR_LOAD(sA, ldwA, va); }
            if (j + 1 < nmine) TR_STORE(dB, ldtB, vb);
        }
    }
#undef TR_DECODE
#undef TR_LOAD
#undef TR_STORE
    const int gt = bx * NTHR + tid, NGT = G * NTHR;
    {   bf16_t* dfts = (bf16_t*)(ws + WS_DFTS);
        for (int e = gt; e < 1024 * 2048 / 8; e += NGT) { const int np = e >> 8, k0 = (e & 255) * 8; float v[8];
#pragma unroll
            for (int i = 0; i < 8; ++i) { const int k = k0 + i; const int j = (np * (k & 1023)) & 1023; const float a = (float)j * (1.f / 512.f); v[i] = (k < 1024 ? cospif(a) : -sinpif(a)) * 0.03125f; }
            u32x4 w; w.x = cvt_pk_bf16(v[0], v[1]); w.y = cvt_pk_bf16(v[2], v[3]); w.z = cvt_pk_bf16(v[4], v[5]); w.w = cvt_pk_bf16(v[6], v[7]); *(u32x4*)(dfts + (size_t)e * 8) = w; }
        bf16_t* dftp = (bf16_t*)(ws + WS_DFTP);
        for (int e = gt; e < 256 * 512 / 8; e += NGT) { const int np = e >> 6, k0 = (e & 63) * 8; float v[8];
#pragma unroll
            for (int i = 0; i < 8; ++i) { const int k = k0 + i; const int j = (np * (k & 255)) & 255; const float a = (float)j * (1.f / 128.f); v[i] = (k < 256 ? cospif(a) : -sinpif(a)) * 0.0625f; }
            u32x4 w; w.x = cvt_pk_bf16(v[0], v[1]); w.y = cvt_pk_bf16(v[2], v[3]); w.z = cvt_pk_bf16(v[4], v[5]); w.w = cvt_pk_bf16(v[6], v[7]); *(u32x4*)(dftp + (size_t)e * 8) = w; }
        bf16_t* gw16 = (bf16_t*)(ws + WS_GW);
        for (int e = gt; e < 4 * 4 * 128 * 128 / 8; e += NGT) { const float* sp = p.gmlp_w + (size_t)e * 8; const f32x4 v0 = *(const f32x4*)sp, v1 = *(const f32x4*)(sp + 4);
            u32x4 w; w.x = cvt_pk_bf16(v0[0], v0[1]); w.y = cvt_pk_bf16(v0[2], v0[3]); w.z = cvt_pk_bf16(v1[0], v1[1]); w.w = cvt_pk_bf16(v1[2], v1[3]); *(u32x4*)(gw16 + (size_t)e * 8) = w; }
        bf16_t* ck = (bf16_t*)(ws + WS_CK);
        for (int e = gt; e < 4 * 4 * 8 * 256 * 8; e += NGT) { const int d8 = (e & 7) * 8, pp_ = (e >> 3) & 255, h = (e >> 11) & 7, b = (e >> 14) & 3, l = e >> 16;
            const float* sp = p.cache_k + ((size_t)((b * 4 + l) * 256 + pp_)) * 512 + h * 64 + d8; const f32x4 v0 = *(const f32x4*)sp, v1 = *(const f32x4*)(sp + 4);
            u32x4 w; w.x = cvt_pk_bf16(v0[0], v0[1]); w.y = cvt_pk_bf16(v0[2], v0[3]); w.z = cvt_pk_bf16(v1[0], v1[1]); w.w = cvt_pk_bf16(v1[2], v1[3]); *(u32x4*)(ck + (size_t)e * 8) = w; }
        bf16_t* cvt = (bf16_t*)(ws + WS_CVT);
        for (int e = gt; e < 4 * 4 * 8 * 8 * 64 * 4; e += NGT) { const int pg = e & 3, d = (e >> 2) & 63, chk = (e >> 8) & 7, h = (e >> 11) & 7, b = (e >> 14) & 3, l = e >> 16;
            const float* sp = p.cache_v + ((size_t)((b * 4 + l) * 256 + chk * 32 + pg * 8)) * 512 + h * 64 + d; float v[8];
#pragma unroll
            for (int i = 0; i < 8; ++i) v[i] = sp[(size_t)i * 512];
            u32x4 w; w.x = cvt_pk_bf16(v[0], v[1]); w.y = cvt_pk_bf16(v[2], v[3]); w.z = cvt_pk_bf16(v[4], v[5]); w.w = cvt_pk_bf16(v[6], v[7]);
            *(u32x4*)(cvt + (size_t)e * 8) = w; }
    }
}

__device__ __forceinline__ void norm_phase(const Params& p, int G, bool first, bool has_prev, bool has_next, float coef, bool dummy,
                                           const float* modp_gate  , const float* npost, const float* modn  , const float* npre) {
    const int tid = opaque_tid(), lane = tid & 63, wave = tid >> 6;
    const int gw = opaque_bx() * NWAVES + wave, NGW = G * NWAVES;
    const float* X = p.out; float* Xo = dummy ? (float*)(p.ws + WS_END) : p.out; const bf16_t* Y0 = (const bf16_t*)(p.ws + WS_Y); const bf16_t* Y1 = Y0 + (size_t)MTOK * DM; bf16_t* H = dummy ? (bf16_t*)(p.ws + WS_END + 32 * MiB) : (bf16_t*)(p.ws + WS_H);
    for (int row = gw; row < MTOK; row += NGW) {
        const int mi = row < MPR ? 0 : 1 + ((row - MPR) >> 10);
        const float* xs = first ? (row < MPR ? p.x_prompt + (size_t)row * DM : p.x_sample + (size_t)(row - MPR) * DM) : X + (size_t)row * DM;
        f32x4 x[4], gt[4], npo[4], sh[4], scl[4], npr[4]; u32x2 ya[4], yb[4];
#pragma unroll
        for (int j = 0; j < 4; ++j) x[j] = *(const f32x4*)(xs + 4 * lane + 256 * j);
        if (has_prev) {
#pragma unroll
            for (int j = 0; j < 4; ++j) { ya[j] = *(const u32x2*)(Y0 + (size_t)row * DM + 4 * lane + 256 * j); yb[j] = *(const u32x2*)(Y1 + (size_t)row * DM + 4 * lane + 256 * j);
                gt[j] = *(const f32x4*)(modp_gate + (size_t)mi * 9216 + 4 * lane + 256 * j); npo[j] = *(const f32x4*)(npost + 4 * lane + 256 * j); }
        }
        if (has_next) {
#pragma unroll
            for (int j = 0; j < 4; ++j) { sh[j] = *(const f32x4*)(modn + (size_t)mi * 9216 + 4 * lane + 256 * j); scl[j] = *(const f32x4*)(modn + (size_t)mi * 9216 + 1024 + 4 * lane + 256 * j);
                npr[j] = *(const f32x4*)(npre + 4 * lane + 256 * j); }
        }
        if (has_prev) {
            f32x4 y[4]; float ss = 0.f;
#pragma unroll
            for (int j = 0; j < 4; ++j) {
                y[j][0] = __uint_as_float(ya[j].x << 16) + __uint_as_float(yb[j].x << 16); y[j][1] = __uint_as_float(ya[j].x & 0xffff0000u) + __uint_as_float(yb[j].x & 0xffff0000u);
                y[j][2] = __uint_as_float(ya[j].y << 16) + __uint_as_float(yb[j].y << 16); y[j][3] = __uint_as_float(ya[j].y & 0xffff0000u) + __uint_as_float(yb[j].y & 0xffff0000u);
                ss += (y[j][0] * y[j][0] + y[j][1] * y[j][1]) + (y[j][2] * y[j][2] + y[j][3] * y[j][3]); }
            const float rs = coef * rsqrtf(wave_sum(ss) * (1.f / DM) + EPS);
#pragma unroll
            for (int j = 0; j < 4; ++j) x[j] += gt[j] * (y[j] * rs * npo[j]);
        }
        u32x2 hw[4];
        if (has_next) {
            float ss = 0.f;
#pragma unroll
            for (int j = 0; j < 4; ++j) ss += (x[j][0] * x[j][0] + x[j][1] * x[j][1]) + (x[j][2] * x[j][2] + x[j][3] * x[j][3]);
            const float rs = rsqrtf(wave_sum(ss) * (1.f / DM) + EPS);
#pragma unroll
            for (int j = 0; j < 4; ++j) { const f32x4 h = (x[j] * rs * npr[j]) * (scl[j] + 1.f) + sh[j]; hw[j].x = cvt_pk_bf16(h[0], h[1]); hw[j].y = cvt_pk_bf16(h[2], h[3]); }
        }
        if (has_prev || first) {
#pragma unroll
            for (int j = 0; j < 4; ++j) *(f32x4*)(Xo + (size_t)row * DM + 4 * lane + 256 * j) = x[j];
        }
        if (has_next) {
#pragma unroll
            for (int j = 0; j < 4; ++j) *(u32x2*)(H + (size_t)row * DM + 4 * lane + 256 * j) = hw[j];
        }
    }
}

#define MFMA16(a, b, c) __builtin_amdgcn_mfma_f32_16x16x32_bf16(a, b, c, 0, 0, 0)
struct AttnCtx { const bf16_t *Kb, *VT, *CKl, *CVTl; int nbr, bh, rlo, nloc, cb, ka, fr, fq; };
__device__ __forceinline__ void attn_load(const AttnCtx& c, int ch, bf16x8 (&kf)[4], bf16x8 (&vf)[4]) {
    const bf16_t* kbase; const bf16_t* vbase; int vpitch;
    if (c.nbr) {
        if (ch < c.nloc) { const int arow = c.rlo + ch; kbase = c.Kb + 2097152 + (size_t)(c.bh * 1024 + arow * 64 + c.cb) * 64; vbase = c.VT + 2097152 + (size_t)(c.bh * 16 + arow) * 4096 + c.cb; vpitch = 64; }
        else { const int cc = min(ch - c.nloc, 7); kbase = c.CKl + (size_t)(c.bh * 256 + cc * 32) * 64; vbase = c.CVTl + (size_t)(c.bh * 8 + cc) * 2048; vpitch = 32; }
    } else { kbase = c.Kb + (size_t)(c.bh * 256 + ch * 32) * 64; vbase = c.VT + (size_t)(c.bh * 8 + ch) * 2048; vpitch = 32; }
    const bf16_t* kp0 = kbase + (size_t)c.ka * 64 + c.fq * 8; const bf16_t* kp1 = kp0 + 4 * 64;
    kf[0] = *(const bf16x8*)kp0; kf[1] = *(const bf16x8*)(kp0 + 32); kf[2] = *(const bf16x8*)kp1; kf[3] = *(const bf16x8*)(kp1 + 32);
#pragma unroll
    for (int dt = 0; dt < 4; ++dt) vf[dt] = *(const bf16x8*)(vbase + (size_t)(dt * 16 + c.fr) * vpitch + c.fq * 8);
}
struct AttnTile { bf16x8 q0, q1; f32x4 o[4]; float m, l; };
__device__ __forceinline__ void attn_step(AttnTile& t, const bf16x8 (&kf)[4], const bf16x8 (&vf)[4], bool local, const LAS float* brow, int kc0, int qc, int cs) {
    f32x4 s0 = {0.f, 0.f, 0.f, 0.f}, s1 = s0;
    s0 = MFMA16(kf[0], t.q0, s0); s0 = MFMA16(kf[1], t.q1, s0); s1 = MFMA16(kf[2], t.q0, s1); s1 = MFMA16(kf[3], t.q1, s1);
    float s[8] = {s0[0], s0[1], s0[2], s0[3], s1[0], s1[1], s1[2], s1[3]};
    if (local) {
        float bias[8];
#pragma unroll
        for (int i = 0; i < 8; ++i) { const int kc = kc0 + i; const bool valid = kc >= cs && kc < cs + 16; bias[i] = brow[valid ? kc : qc]; }
        asm volatile("" : "+v"(bias[0]), "+v"(bias[1]), "+v"(bias[2]), "+v"(bias[3]), "+v"(bias[4]), "+v"(bias[5]), "+v"(bias[6]), "+v"(bias[7]));
#pragma unroll
        for (int i = 0; i < 8; ++i) { const int kc = kc0 + i; const bool valid = kc >= cs && kc < cs + 16; s[i] = valid ? s[i] + bias[i] : -1e30f; }
    }
    float mx = fmaxf(fmaxf(fmaxf(s[0], s[1]), fmaxf(s[2], s[3])), fmaxf(fmaxf(s[4], s[5]), fmaxf(s[6], s[7])));
    mx = fmaxf(mx, __shfl_xor(mx, 16)); mx = fmaxf(mx, __shfl_xor(mx, 32));
    const float mnew = fmaxf(t.m, mx); const float alpha = __expf(t.m - mnew); t.m = mnew;
    float ps = 0.f;
#pragma unroll
    for (int i = 0; i < 8; ++i) { s[i] = __expf(s[i] - mnew); ps += s[i]; }
    t.l = t.l * alpha + ps;
    union { u32x4 w; bf16x8 v; } pb; pb.w.x = cvt_pk_bf16(s[0], s[1]); pb.w.y = cvt_pk_bf16(s[2], s[3]); pb.w.z = cvt_pk_bf16(s[4], s[5]); pb.w.w = cvt_pk_bf16(s[6], s[7]);
#pragma unroll
    for (int dt = 0; dt < 4; ++dt) { t.o[dt] = t.o[dt] * alpha; t.o[dt] = MFMA16(vf[dt], pb.v, t.o[dt]); }
}
struct AttnPair { int nbr, nloc, dB, cb, fq, qc, cs; const LAS float *btA, *btB; };
__device__ __forceinline__ void attn_step2(const AttnPair& P, int ch, AttnTile& A, AttnTile& B, const bf16x8 (&kf)[4], const bf16x8 (&vf)[4]) {
    const int kc0 = P.cb + P.fq * 8;
    if (P.nbr) {
        if (ch < P.nloc) {
            if (ch < 8) attn_step(A, kf, vf, true, P.btA + ch * 31 + 15 - P.qc, kc0, P.qc, P.cs);
            if (ch >= P.dB) attn_step(B, kf, vf, true, P.btB + (ch - P.dB) * 31 + 15 - P.qc, kc0, P.qc, P.cs);
        } else if (ch < P.nloc + 8) { attn_step(A, kf, vf, false, nullptr, kc0, P.qc, P.cs); attn_step(B, kf, vf, false, nullptr, kc0, P.qc, P.cs); }
    } else { attn_step(A, kf, vf, false, nullptr, kc0, P.qc, P.cs); attn_step(B, kf, vf, false, nullptr, kc0, P.qc, P.cs); }
}
__device__ __forceinline__ void attn_finish(AttnTile& t, bf16_t* op) {
    float ls = t.l; ls += __shfl_xor(ls, 16); ls += __shfl_xor(ls, 32);
    const float inv = __builtin_amdgcn_rcpf(ls);
#pragma unroll
    for (int dt = 0; dt < 4; ++dt) { u32x2 w; w.x = cvt_pk_bf16(t.o[dt][0] * inv, t.o[dt][1] * inv); w.y = cvt_pk_bf16(t.o[dt][2] * inv, t.o[dt][3] * inv); *(u32x2*)(op + dt * 16) = w; }
}
__device__ __forceinline__ void attn_wave_unit(int u2, int l, unsigned char* ws, const float* rpb, LAS unsigned char* wl, int lane) {
    const bf16_t* Qb = (const bf16_t*)(ws + WS_Q); bf16_t* O = (bf16_t*)(ws + WS_O);
    AttnCtx c; c.Kb = (const bf16_t*)(ws + WS_K); c.VT = (const bf16_t*)(ws + WS_VT);
    c.CKl = (const bf16_t*)(ws + WS_CK) + (size_t)l * 524288; c.CVTl = (const bf16_t*)(ws + WS_CVT) + (size_t)l * 524288;
    const int fr = lane & 15, fq = lane >> 4; c.fr = fr; c.fq = fq; c.ka = (fr >> 2) * 8 + (fr & 3);
    c.nbr = u2 < 1024;
    AttnPair P; P.nbr = c.nbr; P.fq = fq;
    int h, qrowA, qrowB, nch, rA = 0, rsA = 0, rsB = 0, jb = 0;
    if (c.nbr) { const int b = u2 >> 8; h = (u2 >> 5) & 7; const int rp = (u2 >> 2) & 7; jb = u2 & 3; c.bh = b * 8 + h; rA = 2 * rp;
        rsA = min(max(rA - 4, 0), 8); rsB = min(max(rA - 3, 0), 8); c.rlo = rsA; c.nloc = rsB - rsA + 8; c.cb = min(max(16 * jb - 8, 0), 32);
        qrowA = MPR + b * 1024 + rA * 64 + jb * 16; qrowB = qrowA + 64; nch = (c.nloc + 8 + 1) & ~1; }
    else { const int v = u2 - 1024; const int b = v >> 6; h = (v >> 3) & 7; c.bh = b * 8 + h; c.rlo = 0; c.nloc = 0; c.cb = 0; qrowA = b * 256 + (v & 7) * 32; qrowB = qrowA + 16; nch = 8; }
    P.nloc = c.nloc; P.dB = rsB - rsA; P.cb = c.cb; P.qc = jb * 16 + fr; P.cs = min(max(P.qc - 8, 0), 48);
    LAS float* btab = (LAS float*)wl;
    P.btA = btab; P.btB = btab + 256;
    AttnTile A, B;
    { const bf16_t* qa = Qb + (size_t)(qrowA + fr) * 512 + h * 64 + fq * 8; const bf16_t* qb = Qb + (size_t)(qrowB + fr) * 512 + h * 64 + fq * 8;
      A.q0 = *(const bf16x8*)qa; A.q1 = *(const bf16x8*)(qa + 32); B.q0 = *(const bf16x8*)qb; B.q1 = *(const bf16x8*)(qb + 32); }
    bf16x8 kA[4], vA[4], kB[4], vB[4];
    attn_load(c, 0, kA, vA);
    if (c.nbr) { const float* ra = rpb + ((size_t)l * 8 + h) * 15 * 31 + (rsA - rA + 7) * 31; const float* rb = rpb + ((size_t)l * 8 + h) * 15 * 31 + (rsB - rA - 1 + 7) * 31;
        float t0 = ra[lane], t1 = ra[64 + lane], t2 = ra[128 + lane], t3 = ra[min(192 + lane, 247)], t4 = rb[lane], t5 = rb[64 + lane], t6 = rb[128 + lane], t7 = rb[min(192 + lane, 247)];
        btab[lane] = t0; btab[64 + lane] = t1; btab[128 + lane] = t2; if (lane < 56) btab[192 + lane] = t3;
        btab[256 + lane] = t4; btab[320 + lane] = t5; btab[384 + lane] = t6; if (lane < 56) btab[448 + lane] = t7; }
#pragma unroll
    for (int i = 0; i < 4; ++i) { A.o[i] = (f32x4){0.f, 0.f, 0.f, 0.f}; B.o[i] = (f32x4){0.f, 0.f, 0.f, 0.f}; }
    A.m = -INFINITY; B.m = -INFINITY; A.l = 0.f; B.l = 0.f;
#pragma unroll 1
    for (int ch = 0; ch < nch; ch += 2) {
        attn_load(c, ch + 1, kB, vB);
        attn_step2(P, ch, A, B, kA, vA);
        attn_load(c, min(ch + 2, nch - 1), kA, vA);
        attn_step2(P, ch + 1, A, B, kB, vB);
    }
    attn_finish(A, O + (size_t)(qrowA + fr) * DM + h * 64 + fq * 4);
    attn_finish(B, O + (size_t)(qrowB + fr) * DM + h * 64 + fq * 4);
}

__device__ __forceinline__ void gmlp_wave_unit(int u, int phalf, int l, unsigned char* ws, const float* gn_, const float* gb_, LAS unsigned char* wl, int lane) {
    const bf16_t* Gb = (const bf16_t*)(ws + WS_G); bf16_t* O = (bf16_t*)(ws + WS_O);
    const int fr = lane & 15, fq = lane >> 4;
    const int ck = u >> 2, g = u & 3, row0 = ck * 128, p0 = 4 * phalf;
    const float* gn = gn_ + l * 256; const float* gbias = gb_ + l * 512;
    const bf16_t* gw = (const bf16_t*)(ws + WS_GW) + ((size_t)(l * 4 + g) * 128) * 128;
    LAS bf16_t* vnT = (LAS bf16_t*)wl;
    constexpr int VP = 136;
    u32x4 raw[2][8]; bf16x8 wf[4][4]; u32x2 uu[4][4]; float gbv[4]; f32x4 gnv[4];
#pragma unroll
    for (int half = 0; half < 2; ++half) { const bf16_t* src = Gb + (size_t)(row0 + half * 64 + lane) * 512 + 256 + g * 64;
#pragma unroll
        for (int i = 0; i < 8; ++i) raw[half][i] = *(const u32x4*)(src + 8 * i); }
#define GM_LO(w_) __uint_as_float((w_) << 16)
#define GM_HI(w_) __uint_as_float((w_) & 0xffff0000u)
#pragma unroll
    for (int half = 0; half < 2; ++half) {
        const int t = half * 64 + lane;
        float mu = 0.f;
#pragma unroll
        for (int i = 0; i < 8; ++i)
#pragma unroll
            for (int j = 0; j < 4; ++j) mu += GM_LO(raw[half][i][j]) + GM_HI(raw[half][i][j]);
        mu *= (1.f / 64.f);
        float var = 0.f;
#pragma unroll
        for (int i = 0; i < 8; ++i)
#pragma unroll
            for (int j = 0; j < 4; ++j) { const float a_ = GM_LO(raw[half][i][j]) - mu, b_ = GM_HI(raw[half][i][j]) - mu; var += a_ * a_ + b_ * b_; }
        const float rsd = rsqrtf(var * (1.f / 64.f) + EPS);
#pragma unroll
        for (int i = 0; i < 8; ++i)
#pragma unroll
            for (int j = 0; j < 4; ++j) { const float a_ = (GM_LO(raw[half][i][j]) - mu) * rsd, b_ = (GM_HI(raw[half][i][j]) - mu) * rsd;
                const unsigned pk = cvt_pk_bf16(a_, b_); vnT[(8 * i + 2 * j) * VP + t] = (bf16_t)(pk & 0xffffu); vnT[(8 * i + 2 * j + 1) * VP + t] = (bf16_t)(pk >> 16); }
    }
#undef GM_LO
#undef GM_HI
    LDS_WAIT(); asm volatile("" ::: "memory");
#pragma unroll
    for (int pt = 0; pt < 4; ++pt) { const bf16_t* wp = gw + (size_t)((p0 + pt) * 16 + fr) * 128 + fq * 8;
#pragma unroll
        for (int ks = 0; ks < 4; ++ks) wf[pt][ks] = *(const bf16x8*)(wp + ks * 32);
#pragma unroll
        for (int ct = 0; ct < 4; ++ct) uu[pt][ct] = *(const u32x2*)(Gb + (size_t)(row0 + (p0 + pt) * 16 + fr) * 512 + g * 64 + ct * 16 + fq * 4);
        gbv[pt] = gbias[g * 128 + (p0 + pt) * 16 + fr]; }
#pragma unroll
    for (int ct = 0; ct < 4; ++ct) gnv[ct] = *(const f32x4*)(gn + g * 64 + ct * 16 + fq * 4);
#pragma unroll
    for (int pt = 0; pt < 4; ++pt) {
        const int row_ = row0 + (p0 + pt) * 16 + fr; const float GB = gbv[pt];
#pragma unroll
        for (int ct = 0; ct < 4; ++ct) { f32x4 acc = {0.f, 0.f, 0.f, 0.f};
#pragma unroll
            for (int ks = 0; ks < 4; ++ks) { const bf16x8 a_ = *(const LAS bf16x8*)(vnT + (ct * 16 + fr) * VP + ks * 32 + fq * 8); acc = MFMA16(a_, wf[pt][ks], acc); }
            const u32x2 uw = uu[pt][ct]; const f32x4 gq = gnv[ct];
            const float u0 = __uint_as_float(uw.x << 16), u1 = __uint_as_float(uw.x & 0xffff0000u), u2 = __uint_as_float(uw.y << 16), u3 = __uint_as_float(uw.y & 0xffff0000u);
            u32x2 w_; w_.x = cvt_pk_bf16(u0 * (acc[0] * gq[0] + GB), u1 * (acc[1] * gq[1] + GB)); w_.y = cvt_pk_bf16(u2 * (acc[2] * gq[2] + GB), u3 * (acc[3] * gq[3] + GB));
            *(u32x2*)(O + (size_t)row_ * DM + 768 + g * 64 + ct * 16 + fq * 4) = w_; }
    }
    LDS_WAIT(); asm volatile("" ::: "memory");
}

#define XB_TMO      128
#define XB_XCNT(j)  (256  + 64 * (j))
#define XB_XSUB(j)  (1280 + 64 * (j))
#define XB_XGEN(j)  (2304 + 64 * (j))
#define XB_TOP      3328
#define XB_TOPGEN   3392
#define XCD_BAR_WORDS 3456
#define XB_SPIN_CAP (1u << 18)
__device__ __forceinline__ unsigned xb_ld(unsigned* p)              { return __hip_atomic_load(p, __ATOMIC_RELAXED, __HIP_MEMORY_SCOPE_AGENT); }
__device__ __forceinline__ unsigned xb_add(unsigned* p, unsigned v) { return __hip_atomic_fetch_add(p, v, __ATOMIC_RELAXED, __HIP_MEMORY_SCOPE_AGENT); }
__device__ __forceinline__ unsigned xb_xcc_id() { return (unsigned)__builtin_amdgcn_s_getreg((3 << 11) | 20) & 0xFu; }
#define XB_SPIN(cond, bar) do { unsigned _sp = 0; while (cond) { __builtin_amdgcn_s_sleep(1); \
    if ((++_sp & 255u) == 0u) { if (xb_ld(&(bar)[XB_TMO])) break; if (_sp > XB_SPIN_CAP) { atomicAdd(&(bar)[XB_TMO], 1u); break; } } } } while (0)
__device__ __forceinline__ void xcd_barrier_complete(unsigned* bar, unsigned x, unsigned& nloc, unsigned& nx) {
    const unsigned G = gridDim.x * gridDim.y * gridDim.z;
    unsigned sum, cnt, mine, sp = 0u;
    for (;;) {
        sum = 0u; cnt = 0u; mine = 0u;
#pragma unroll
        for (unsigned j = 0; j < 16; ++j) { const unsigned c = xb_ld(&bar[XB_XCNT(j)]); sum += c; cnt += (c > 0u) ? 1u : 0u; mine = (j == x) ? c : mine; }
        if (sum == G) break;
        __builtin_amdgcn_s_sleep(1);
        if ((++sp & 255u) == 0u) { if (xb_ld(&bar[XB_TMO])) break; if (sp > XB_SPIN_CAP) { atomicAdd(&bar[XB_TMO], 1u); break; } }
    }
    nloc = mine > 0u ? mine : 1u; nx = cnt > 0u ? cnt : 1u;
}
__device__ __forceinline__ void xcd_barrier(unsigned* bar, volatile LAS unsigned* st) {
    asm volatile("s_waitcnt vmcnt(0)" ::: "memory");
    __syncthreads();
    if (opaque_tid() == 0) {
        __builtin_amdgcn_s_waitcnt(0);
        const unsigned x = xb_xcc_id();
        unsigned nloc = st[0], nx = st[1];
        if (nloc == 0u) { xcd_barrier_complete(bar, x, nloc, nx); st[0] = nloc; st[1] = nx; }
        const unsigned old = xb_add(&bar[XB_XSUB(x)], 1u);
        const unsigned gen = old / nloc;
        if (old + 1u == (gen + 1u) * nloc) {
            __builtin_amdgcn_fence(__ATOMIC_RELEASE, "agent");
            asm volatile("s_waitcnt vmcnt(0)" ::: "memory");
            const unsigned og = xb_add(&bar[XB_TOP], 1u);
            const unsigned tg = og / nx;
            if (og + 1u == (tg + 1u) * nx) xb_add(&bar[XB_TOPGEN], 1u);
            else XB_SPIN(xb_ld(&bar[XB_TOPGEN]) == tg, bar);
            __builtin_amdgcn_fence(__ATOMIC_ACQUIRE, "agent");
            xb_add(&bar[XB_XGEN(x)], 1u);
            asm volatile("s_waitcnt vmcnt(0)" ::: "memory");
        } else {
            XB_SPIN(xb_ld(&bar[XB_XGEN(x)]) == gen, bar);
            __builtin_amdgcn_fence(__ATOMIC_ACQUIRE, "agent");
            asm volatile("s_waitcnt vmcnt(0)" ::: "memory");
        }
    }
    __syncthreads();
}
constexpr int CW_BAR = 4096;
constexpr int LDS_BARW = 147200;

#ifndef PROBE_SYNC
#define PROBE_SYNC 0
#endif
#ifndef PROBE_MIX
#define PROBE_MIX 0
#endif
#ifndef PROBE_PRO
#define PROBE_PRO 0
#endif
#ifndef PROBE_NORM
#define PROBE_NORM 0
#endif
#ifndef PROBE_G
#define PROBE_G 0
#endif
#define XSYNC() xcd_barrier((unsigned*)(pp->ws + WS_CTL) + CW_BAR, (volatile LAS unsigned*)(lds + LDS_BARW))
#define GSYNC() do { LAUNDER(pp); XSYNC(); if (PROBE_SYNC) { LAUNDER(pp); XSYNC(); } } while (0)
#if defined(__HIP_DEVICE_COMPILE__)
typedef const __attribute__((address_space(4))) Params* PP;
#else
typedef const Params* PP;
#endif
#define LAUNDER(pp) asm volatile("" : "+s"(pp) :: "memory")
#define LOADP(pp) (*(const Params*)(pp))

__device__ __forceinline__ void norm_step(PP pp, int l, int sub, bool dummy = false) {
    const Params p = *pp;
    const int G = gridDim.x;
    const float* mod = (const float*)(p.ws + WS_MOD);
    if (sub == 0) { const int lp = l > 0 ? l - 1 : 0;
        norm_phase(p, G, l == 0, l > 0, true, 0.5f, dummy, mod + (size_t)lp * 5 * 9216 + 8 * 1024, p.norm_post + (lp * 3 + 2) * DM, mod + (size_t)l * 5 * 9216, p.norm_pre + (l * 3 + 0) * DM); }
    else if (sub == 1) norm_phase(p, G, false, true, true, 0.5f, dummy, mod + (size_t)l * 5 * 9216 + 2 * 1024, p.norm_post + (l * 3 + 0) * DM, mod + (size_t)l * 5 * 9216 + 3 * 1024, p.norm_pre + (l * 3 + 1) * DM);
    else if (sub == 2) norm_phase(p, G, false, true, true, 1.0f, dummy, mod + (size_t)l * 5 * 9216 + 5 * 1024, p.norm_post + (l * 3 + 1) * DM, mod + (size_t)l * 5 * 9216 + 6 * 1024, p.norm_pre + (l * 3 + 2) * DM);
    else norm_phase(p, G, false, true, false, 0.5f, dummy, mod + (size_t)3 * 5 * 9216 + 8 * 1024, p.norm_post + (3 * 3 + 2) * DM, mod, p.norm_pre);
}

__global__ void __launch_bounds__(NTHR, 2) fwd_kernel(Params p_unused) {
    extern __shared__ __attribute__((aligned(16))) unsigned char lds_raw[];
    LAS unsigned char* lds = (LAS unsigned char*)lds_raw;
    cg::grid_group grid = cg::this_grid();
    PP pp = (PP)__builtin_amdgcn_kernarg_segment_ptr();
    LAUNDER(pp);
    if (threadIdx.x == 0) { ((volatile LAS unsigned*)(lds + LDS_BARW))[0] = 0u; ((volatile LAS unsigned*)(lds + LDS_BARW))[1] = 0u;
        (void)xb_add((unsigned*)(pp->ws + WS_CTL) + CW_BAR + XB_XCNT(xb_xcc_id()), 1u); }
    __syncthreads();
    { const Params p = *pp; prologue(p, lds, gridDim.x); }
    if (PROBE_PRO) { GSYNC(); LAUNDER(pp); const Params p = *pp; prologue(p, lds, gridDim.x); }
    GSYNC();
    {
        LAUNDER(pp); const Params p = *pp; const int gt = opaque_bx() * NTHR + opaque_tid(), NGT = gridDim.x * NTHR;
        const f32x4* part = (const f32x4*)(p.ws + WS_Y); f32x4* mod4 = (f32x4*)(p.ws + WS_MOD);
        constexpr int NQ = NLAYER * 5 * 9216 / 4;
        for (int e = gt; e < NQ; e += NGT) { const int l = e / (5 * 2304), n4 = e % 2304;
            mod4[e] = ((part[e] + part[NQ + e]) + (part[2 * NQ + e] + part[3 * NQ + e])) + *(const f32x4*)(p.ada_b + l * 9216 + n4 * 4); }
    }
    GSYNC();
    if (gridDim.y == 0xFFFFu) grid.sync();

#pragma unroll 1
    for (int l = 0; l < NLAYER; ++l) {
        LAUNDER(pp);
        if (PROBE_NORM) { norm_step(pp, l, 0, true); LAUNDER(pp); }
        norm_step(pp, l, 0);
        GSYNC();
#pragma unroll 1
        for (int s = 0; s < 2; ++s) {
            LAUNDER(pp);
#pragma unroll 1
            for (int rep = 0; rep <= ((PROBE_G & 1) ? 1 : 0); ++rep) {
                LAUNDER(pp);
                unsigned char* ws = pp->ws; const unsigned char* wl = ws + WS_W + (size_t)l * W_LAYER;
                pg8::Gemm g{(const bf16_t*)(ws + WS_H), (const bf16_t*)(wl + W_FWI + s * SZ_FWI)}; pg8::StaticOrder S; S.init(MTOK / 256, NFI / 256, 1, gridDim.x, opaque_bx());
                EpiSwiglu E{ws};
                pg8::gemm_phase<DM, DM, DM, EpiSwiglu, pg8::StaticOrder>(lds, g, S, E);
                if (rep == 0 && opaque_bx() >= 192 && (s == 0 || l + 1 < NLAYER)) {
                    LAUNDER(pp); const Params p = *pp;
                    fwi0_items(p, lds, s == 0 ? l : l + 1, s == 0 ? 1 : 0, (opaque_bx() - 192) * NWAVES, 64 * NWAVES);
                }
            }
            GSYNC();
            LAUNDER(pp);
#pragma unroll 1
            for (int rep = 0; rep <= ((PROBE_G & 2) ? 1 : 0); ++rep) {
                LAUNDER(pp);
                unsigned char* ws = pp->ws; const unsigned char* wl = ws + WS_W + (size_t)l * W_LAYER;
                pg8::Gemm g{(const bf16_t*)(ws + WS_A2), (const bf16_t*)(wl + W_FWO + s * SZ_FWO)}; pg8::StaticOrder S; S.init(MTOK / 256, DM / 256, 2, gridDim.x, opaque_bx());
                EpiF32 E{ws};
                pg8::gemm_phase<FF, FF, FF / 2, EpiF32, pg8::StaticOrder>(lds, g, S, E);
            }
            GSYNC();
            if (s == 1) break;
            LAUNDER(pp);
            if (PROBE_NORM) { norm_step(pp, l, 1, true); LAUNDER(pp); }
            norm_step(pp, l, 1);
            GSYNC();
            LAUNDER(pp);
            {
                LAUNDER(pp);
                unsigned char* ws = pp->ws; const unsigned char* wl = ws + WS_W + (size_t)l * W_LAYER;
                pg8::Gemm g{(const bf16_t*)(ws + WS_H), (const bf16_t*)(wl + W_WIN)}; pg8::StaticOrder S; S.init(MTOK / 256, 8, 1, gridDim.x, opaque_bx());
                EpiMixIn E{ws, pp->out, l};
                pg8::gemm_phase<DM, DM, DM, EpiMixIn, pg8::StaticOrder>(lds, g, S, E);
            }
            GSYNC();
            LAUNDER(pp);
            {
                unsigned char* ws = pp->ws; const unsigned char* wl = ws + WS_W + (size_t)l * W_LAYER;
                const int bx = opaque_bx();
                const int tid_ = opaque_tid(); const int lane = tid_ & 63, wave = __builtin_amdgcn_readfirstlane(tid_ >> 6);
                LAS unsigned* wcnt = (LAS unsigned*)(lds + LDS_BARW + 16);
                if (bx < 64) {
                    {   pg8::Gemm g{(const bf16_t*)(ws + WS_H), (const bf16_t*)(wl + W_WIN)}; pg8::SubsetOrder S{0, 32, 64, bx, 8};
                        EpiMixIn E{ws, pp->out, l};
                        pg8::gemm_phase<DM, DM, DM, EpiMixIn, pg8::SubsetOrder>(lds, g, S, E); }
                    LAUNDER(pp);
                    unsigned* tcnt = (unsigned*)(pp->ws + WS_CTL) + 2048 + 64 * l;
                    asm volatile("s_waitcnt vmcnt(0)" ::: "memory"); __syncthreads();
                    if (tid_ == 0) { __builtin_amdgcn_fence(__ATOMIC_RELEASE, "agent"); asm volatile("s_waitcnt vmcnt(0)" ::: "memory"); (void)xb_add(tcnt, 1u);
                        unsigned sp = 0u; while (xb_ld(tcnt) < 64u) { __builtin_amdgcn_s_sleep(2); if (++sp > (1u << 22)) break; }
                        __builtin_amdgcn_fence(__ATOMIC_ACQUIRE, "agent"); asm volatile("s_waitcnt vmcnt(0)" ::: "memory"); *wcnt = 0u; }
                    __syncthreads();
                    for (;;) {
                        unsigned n = 0; if (lane == 0) n = __hip_atomic_fetch_add(wcnt, 1u, __ATOMIC_RELAXED, __HIP_MEMORY_SCOPE_WORKGROUP); n = __builtin_amdgcn_readfirstlane(n);
                        if (n >= 8u) break;
                        LAUNDER(pp);
                        gmlp_wave_unit(bx * 4 + (int)(n >> 1), (int)(n & 1u), l, pp->ws, pp->gmlp_norm, pp->gmlp_b, lds + wave * 17408, lane);
                    }
                } else if (bx < 96) {
                    {   pg8::Gemm g{(const bf16_t*)(ws + WS_DFTS), (const bf16_t*)(ws + WS_TT) + 2097152}; pg8::SubsetOrder S{64, 4, 16, bx, 0};
                        EpiFourier E{ws, MPR, 1024};
                        pg8::gemm_phase<2048, 2048, 2048, EpiFourier, pg8::SubsetOrder>(lds, g, S, E); }
                    LAUNDER(pp); ws = pp->ws;
                    {   pg8::Gemm g{(const bf16_t*)(ws + WS_DFTP), (const bf16_t*)(ws + WS_TT)}; pg8::SubsetOrder S{80, 1, 16, bx, 0};
                        EpiFourier E{ws, 0, 256};
                        pg8::gemm_phase<512, 512, 512, EpiFourier, pg8::SubsetOrder>(lds, g, S, E); }
                }
                __syncthreads();
                if (tid_ == 0) *wcnt = 0u;
                __syncthreads();
                const int sh = bx < 96 ? 0 : 1, cs0 = bx < 96 ? 0 : bx - 96;
                const int i0 = cs0 * 2048 / 160, i1 = (cs0 + sh) * 2048 / 160;
                for (;;) {
                    if (gridDim.x != 256) break;
                    unsigned n = 0; if (lane == 0) n = __hip_atomic_fetch_add(wcnt, 1u, __ATOMIC_RELAXED, __HIP_MEMORY_SCOPE_WORKGROUP); n = __builtin_amdgcn_readfirstlane(n);
                    const int e0 = (i0 + 1) & ~1, ne = i1 > e0 ? (i1 - e0 + 1) >> 1 : 0, o0 = i0 | 1;
                    const int i = (int)n < ne ? e0 + 2 * (int)n : o0 + 2 * ((int)n - ne);
                    if (i >= i1) break;
                    LAUNDER(pp);
                    attn_wave_unit((i & 1) * 1024 + (i >> 1), l, pp->ws, pp->rpb, lds + wave * 17408, lane);
                }
            }
            GSYNC();
            LAUNDER(pp);
#pragma unroll 1
            for (int rep = 0; rep <= ((PROBE_G & 8) ? 1 : 0); ++rep) {
                LAUNDER(pp);
                unsigned char* ws = pp->ws; const unsigned char* wl = ws + WS_W + (size_t)l * W_LAYER;
                pg8::Gemm g{(const bf16_t*)(ws + WS_O), (const bf16_t*)(wl + W_WOUT)}; pg8::StaticOrder S; S.init(MTOK / 256, DM / 256, 2, gridDim.x, opaque_bx());
                EpiF32 E{ws};
                pg8::gemm_phase<DM, DM, DM / 2, EpiF32, pg8::StaticOrder>(lds, g, S, E);
            }
            GSYNC();
            LAUNDER(pp);
            if (PROBE_NORM) { norm_step(pp, l, 2, true); LAUNDER(pp); }
            norm_step(pp, l, 2);
            GSYNC();
        }
    }
    LAUNDER(pp);
    if (PROBE_NORM) { norm_step(pp, 0, 3, true); LAUNDER(pp); }
    norm_step(pp, 0, 3);
}

extern "C" void kernel_launch(void* const* d_in, const int* in_sizes, int n_in, void* d_out, int out_size, void* d_ws, size_t ws_size, hipStream_t stream) {
    static int grid = 0;
    if (grid == 0) {
        if (n_in != 18 || ws_size < WS_END) { fprintf(stderr, "kernel_launch: need 18 inputs and >= %zu bytes of workspace (got %d, %zu)\n", (size_t)WS_END, n_in, ws_size); grid = -1; return; }
        int dev = 0, cus = 0, per_cu = 0;
        hipGetDevice(&dev); hipDeviceGetAttribute(&cus, hipDeviceAttributeMultiprocessorCount, dev);
        if (hipFuncSetAttribute((const void*)fwd_kernel, hipFuncAttributeMaxDynamicSharedMemorySize, LDS_BYTES) != hipSuccess) { fprintf(stderr, "kernel_launch: hipFuncSetAttribute failed\n"); grid = -1; return; }
        if (hipOccupancyMaxActiveBlocksPerMultiprocessor(&per_cu, (const void*)fwd_kernel, NTHR, LDS_BYTES) != hipSuccess || per_cu < 1) { fprintf(stderr, "kernel_launch: occupancy query failed (%d)\n", per_cu); per_cu = 1; }
        (void)hipGetLastError();
        grid = cus * 1;
        fprintf(stderr, "kernel_launch: grid %d (per_cu %d)\n", grid, per_cu);
    }
    if (grid < 0) return;
    (void)hipMemsetAsync((char*)d_ws + WS_CTL, 0, CTL_BYTES, stream);
    Params p{};
    p.x_prompt = (const float*)d_in[0]; p.x_sample = (const float*)d_in[1]; p.cache_k = (const float*)d_in[2]; p.cache_v = (const float*)d_in[3];
    p.c = (const float*)d_in[4]; p.c_ctx = (const float*)d_in[5]; p.ada_w = (const float*)d_in[6]; p.ada_b = (const float*)d_in[7];
    p.norm_pre = (const float*)d_in[8]; p.norm_post = (const float*)d_in[9]; p.ffn_w_in = (const float*)d_in[10]; p.ffn_w_out = (const float*)d_in[11];
    p.w_in = (const float*)d_in[12]; p.w_out = (const float*)d_in[13]; p.rpb = (const float*)d_in[14]; p.gmlp_norm = (const float*)d_in[15];
    p.gmlp_w = (const float*)d_in[16]; p.gmlp_b = (const float*)d_in[17];
    p.out = (float*)d_out; p.ws = (unsigned char*)d_ws;
    void* args[] = {&p};
    hipError_t e = hipLaunchCooperativeKernel((const void*)fwd_kernel, dim3(grid), dim3(NTHR), args, LDS_BYTES, stream);
    if (e != hipSuccess) fprintf(stderr, "kernel_launch: cooperative launch failed: %s (grid %d)\n", hipGetErrorString(e), grid);
}
```

```cpp
#include <hip/hip_runtime.h>
#include <hip/hip_cooperative_groups.h>
#include <cstdio>
#include <cstdint>
namespace cg = cooperative_groups;

#define LAS __attribute__((address_space(3)))
typedef unsigned short bf16_t;
typedef short bf16x8 __attribute__((ext_vector_type(8)));
typedef float f32x4 __attribute__((ext_vector_type(4)));
typedef unsigned u32x4 __attribute__((ext_vector_type(4)));
typedef unsigned u32x2 __attribute__((ext_vector_type(2)));

constexpr int DM = 1024, MTOK = 8192, MPR = 4096, FF = 2816, NFI = 2 * FF, NMI = 2560, NLAYER = 4;
constexpr int NWAVES = 8, NTHR = 512;
constexpr int LDS_BYTES = 147456;
constexpr float EPS = 1e-6f;

constexpr size_t MiB = 1u << 20;
constexpr size_t WS_CTL = 0, CTL_BYTES = 65536;
constexpr size_t WS_MOD = 1 * MiB;
constexpr size_t WS_DFTS = 2 * MiB;
constexpr size_t WS_DFTP = 6 * MiB;
constexpr size_t WS_CK = 7 * MiB;
constexpr size_t WS_CVT = 11 * MiB;
constexpr size_t WS_GW = 15 * MiB;
constexpr size_t WS_H = 16 * MiB;
constexpr size_t WS_Q = 32 * MiB;
constexpr size_t WS_K = 40 * MiB;
constexpr size_t WS_VT = 48 * MiB;
constexpr size_t WS_TT = 56 * MiB;
constexpr size_t WS_G = 64 * MiB;
constexpr size_t WS_O = 72 * MiB;
constexpr size_t WS_A2 = 88 * MiB;
constexpr size_t WS_Y = 136 * MiB;
constexpr size_t WS_W = 200 * MiB;
constexpr size_t W_FWI = 0, SZ_FWI = (size_t)NFI * DM * 2;
constexpr size_t W_FWO = 2 * SZ_FWI, SZ_FWO = (size_t)DM * FF * 2;
constexpr size_t W_WIN = W_FWO + 2 * SZ_FWO, SZ_WIN = (size_t)NMI * DM * 2;
constexpr size_t W_WOUT = W_WIN + SZ_WIN, SZ_WOUT = (size_t)DM * DM * 2;
constexpr size_t W_LAYER = W_WOUT + SZ_WOUT;
constexpr size_t WS_END = WS_W + NLAYER * W_LAYER;

struct Params {
    const float *x_prompt, *x_sample, *cache_k, *cache_v, *c, *c_ctx, *ada_w, *ada_b, *norm_pre, *norm_post, *ffn_w_in, *ffn_w_out, *w_in, *w_out, *rpb, *gmlp_norm, *gmlp_w, *gmlp_b;
    float* out; unsigned char* ws;
};

__device__ __forceinline__ unsigned cvt_pk_bf16(float lo, float hi) { unsigned r; asm volatile("v_cvt_pk_bf16_f32 %0, %1, %2" : "=v"(r) : "v"(lo), "v"(hi)); return r; }
__device__ __forceinline__ float wave_sum(float v) {
#pragma unroll
    for (int o = 1; o < 64; o <<= 1) v += __shfl_xor(v, o);
    return v;
}
#define LDS_WAIT() asm volatile("s_waitcnt lgkmcnt(0)" ::: "memory")
__device__ __forceinline__ int opaque_bx() { int b = blockIdx.x; asm volatile("" : "+s"(b)); return b; }
__device__ __forceinline__ int opaque_tid() { int t = threadIdx.x; asm volatile("" : "+v"(t)); return t; }

namespace pg8 {
constexpr int BM = 256, BK = 64, HALF = 128, HTB = HALF * BK * 2, STAGE_BYTES = 8 * HTB, NXCD = 8, WGM = 8;
__host__ __device__ __forceinline__ int lds_byte(int r, int c) { const int st = (r >> 4) * 2 + (c >> 5), rr = r & 15, cc = c & 31, ob = rr * 64 + cc * 2; return st * 1024 + (ob ^ (((ob >> 9) & 1) << 5)); }
__host__ __device__ __forceinline__ void stage_rc(int b, int& R, int& C) { const int st = b / 1024, sb = b % 1024, swz = sb ^ (((sb >> 9) & 1) << 5); R = (st >> 1) * 16 + swz / 64; C = (st & 1) * 32 + (swz % 64) / 2; }
__host__ __device__ __forceinline__ int perm32(int rho) { const int n = rho >> 4, i = rho & 15; return 8 * (i >> 2) + 4 * n + (i & 3); }

struct Unit { int pm, pn, ks; };
struct Gemm { const bf16_t* A; const bf16_t* Bt; };

struct StaticOrder {
    int nM, nN, nwg, G, c, nMr, gap_at, gap;
    __device__ void init(int nM_, int nN_, int ksplit, int G_, int c_, int gap_at_ = 1 << 20, int gap_ = 0) { nMr = nM_; nM = nM_ * ksplit; nN = nN_; nwg = nM * nN; G = G_; c = c_; gap_at = gap_at_; gap = gap_; }
    __device__ bool next(int i, Unit& u) const {
        const long L = (long)i * G + c; if (L >= nwg) return false;
        int wgid = (int)L; { const int q = nwg / NXCD, r = nwg % NXCD, xcd = wgid % NXCD, off = wgid / NXCD; wgid = (xcd < r ? xcd * (q + 1) : r * (q + 1) + (xcd - r) * q) + off; }
        const int nig = WGM * nN, gid = wgid / nig, fm = gid * WGM, gsz = (nM - fm) < WGM ? (nM - fm) : WGM;
        const int pmv = fm + ((wgid % nig) % gsz); u.pn = (wgid % nig) / gsz; if (u.pn >= gap_at) u.pn += gap; u.ks = pmv / nMr; u.pm = pmv % nMr; return true;
    }
};
struct SubsetOrder {
    int c0, nM, n, c, pn0;
    __device__ bool next(int i, Unit& u) const { const int j = c - c0; if (i != 0 || j < 0 || j >= n) return false; u.pm = j % nM; u.pn = pn0 + j / nM; u.ks = 0; return true; }
};

template <int LDA, int LDB, int KLOOP, class Epi, class Sched, bool ALIGN_EPI = true, bool SP2 = true>
__device__ __forceinline__ void gemm_phase(LAS unsigned char* lds, const Gemm g, const Sched& S, const Epi& E) {
    const int tid = opaque_tid(), wid = __builtin_amdgcn_readfirstlane(tid >> 6), lane = tid & 63, wr = wid >> 2, wc = wid & 3, fr = lane & 15, fq = lane >> 4;
    constexpr int nt = KLOOP / BK;
    unsigned voffA[2], voffB[2];
#pragma unroll
    for (int i = 0; i < 2; ++i) { int R, C; stage_rc(tid * 16 + i * 8192, R, C); const int Rb = Epi::PERM ? ((R & ~31) + perm32(R & 31)) : R;
        voffA[i] = (unsigned)(R * LDA + C) * 2u; voffB[i] = (unsigned)(Rb * LDB + C) * 2u; }
    constexpr size_t kstep = (size_t)(BK * 2);
    constexpr size_t hstepA = (size_t)HALF * LDA * 2, hstepB = (size_t)HALF * LDB * 2;
    constexpr size_t tstepA = 2 * hstepA, tstepB = 2 * hstepB;
    const unsigned ldsw = (unsigned)wid * 1024u;
    const int aoff = lds_byte(wr * 64 + fr, fq * 8), boff = lds_byte(wc * 32 + fr, fq * 8);
#define PG8_SA(b, h) (((b) * 2 + (h)) * HTB)
#define PG8_SB(b, h) ((4 + (b) * 2 + (h)) * HTB)
#define PG8_STAGE(bufoff, gbase, voff) do { _Pragma("unroll") for (int _i = 0; _i < 2; ++_i) \
        __builtin_amdgcn_global_load_lds((const unsigned*)((const char*)(gbase) + (voff)[_i]), (LAS unsigned*)(lds + (bufoff) + ldsw + _i * 8192), 16, 0, 0); } while (0)
#define PG8_LDA(dst, b, h) do { _Pragma("unroll") for (int m = 0; m < 4; ++m) _Pragma("unroll") for (int k = 0; k < 2; ++k) dst[m][k] = *(const LAS bf16x8*)(lds + PG8_SA(b, h) + aoff + m * 2048 + k * 1024); } while (0)
#define PG8_LDB(dst, b, h) do { _Pragma("unroll") for (int n = 0; n < 2; ++n) _Pragma("unroll") for (int k = 0; k < 2; ++k) dst[n][k] = *(const LAS bf16x8*)(lds + PG8_SB(b, h) + boff + n * 2048 + k * 1024); } while (0)
#define PG8_MMA(ai, bj, At, Bt) do { __builtin_amdgcn_s_setprio(1); _Pragma("unroll") for (int m = 0; m < 4; ++m) _Pragma("unroll") for (int n = 0; n < 2; ++n) _Pragma("unroll") for (int k = 0; k < 2; ++k) \
        acc[ai][bj][m][n] = __builtin_amdgcn_mfma_f32_16x16x32_bf16(Bt[n][k], At[m][k], acc[ai][bj][m][n], 0, 0, 0); __builtin_amdgcn_s_setprio(0); } while (0)
#define PG8_WAIT_V(n) asm volatile("s_waitcnt vmcnt(" #n ")" ::: "memory")
#define PG8_WAIT_L(n) asm volatile("s_waitcnt lgkmcnt(" #n ")" ::: "memory")
#define PG8_BAR __builtin_amdgcn_s_barrier()
#define PG8_SCHED __builtin_amdgcn_sched_barrier(0)
    Unit cur, nxt; int ui = 0;
    if (!S.next(0, cur)) return;
    f32x4 acc[2][2][4][2];
#pragma unroll
    for (int a = 0; a < 2; ++a)
#pragma unroll
        for (int b = 0; b < 2; ++b)
#pragma unroll
            for (int m = 0; m < 4; ++m)
#pragma unroll
                for (int n = 0; n < 2; ++n) acc[a][b][m][n] = (f32x4){0.f, 0.f, 0.f, 0.f};
    bf16x8 At[4][2], B0[2][2], B1[2][2];
    constexpr size_t ksoff = (size_t)KLOOP * 2;
    const char* cA = (const char*)g.A + (size_t)cur.pm * tstepA + (size_t)cur.ks * ksoff; const char* cB = (const char*)g.Bt + (size_t)cur.pn * tstepB + (size_t)cur.ks * ksoff;
    if constexpr (SP2) {
        PG8_STAGE(PG8_SB(0, 0), cB, voffB); PG8_STAGE(PG8_SB(0, 1), cB + hstepB, voffB); PG8_STAGE(PG8_SA(0, 0), cA, voffA); PG8_STAGE(PG8_SA(0, 1), cA + hstepA, voffA);
        if (wr == 1) PG8_BAR;
        PG8_WAIT_V(2); PG8_BAR;
        PG8_STAGE(PG8_SB(1, 0), cB + kstep, voffB); PG8_STAGE(PG8_SA(1, 0), cA + kstep, voffA); PG8_STAGE(PG8_SB(1, 1), cB + hstepB + kstep, voffB);
        PG8_WAIT_V(6); PG8_BAR;
    }
    for (;;) {
        const bool has_next = S.next(ui + 1, nxt);
        const char* nA = has_next ? (const char*)g.A + (size_t)nxt.pm * tstepA + (size_t)nxt.ks * ksoff : cA; const char* nB = has_next ? (const char*)g.Bt + (size_t)nxt.pn * tstepB + (size_t)nxt.ks * ksoff : cB;
        for (int t = 0; t < nt; t += 2) {
            const bool last = (t == nt - 2);
            const char* a1 = cA + (size_t)(t + 1) * kstep;
            const char* a2 = last ? nA : cA + (size_t)(t + 2) * kstep; const char* b2 = last ? nB : cB + (size_t)(t + 2) * kstep;
            const char* a3 = a2 + kstep; const char* b3 = b2 + kstep;
            PG8_LDB(B0, 0, 0); PG8_LDB(B1, 0, 1); PG8_SCHED; PG8_LDA(At, 0, 0); PG8_STAGE(PG8_SA(1, 1), a1 + hstepA, voffA);
            PG8_WAIT_V(8); PG8_WAIT_L(0); PG8_BAR; PG8_MMA(0, 0, At, B0); PG8_MMA(0, 1, At, B1); PG8_BAR; PG8_SCHED;
            PG8_LDA(At, 0, 1); PG8_STAGE(PG8_SB(0, 0), b2, voffB); PG8_STAGE(PG8_SB(0, 1), b2 + hstepB, voffB); PG8_STAGE(PG8_SA(0, 0), a2, voffA);
            PG8_WAIT_V(8); PG8_WAIT_L(0); PG8_BAR; PG8_MMA(1, 0, At, B0); PG8_MMA(1, 1, At, B1); PG8_BAR; PG8_SCHED;
            PG8_LDB(B0, 1, 0); PG8_LDB(B1, 1, 1); PG8_SCHED; PG8_LDA(At, 1, 0); PG8_STAGE(PG8_SA(0, 1), a2 + hstepA, voffA);
            PG8_WAIT_V(8); PG8_WAIT_L(0); PG8_BAR; PG8_MMA(0, 0, At, B0); PG8_MMA(0, 1, At, B1); PG8_BAR; PG8_SCHED;
            PG8_LDA(At, 1, 1); PG8_STAGE(PG8_SB(1, 0), b3, voffB); PG8_STAGE(PG8_SB(1, 1), b3 + hstepB, voffB); PG8_STAGE(PG8_SA(1, 0), a3, voffA);
            PG8_WAIT_V(8); PG8_WAIT_L(0); PG8_BAR; PG8_MMA(1, 0, At, B0); PG8_MMA(1, 1, At, B1); PG8_BAR; PG8_SCHED;
        }
        if constexpr (ALIGN_EPI) { if (wr == 0) PG8_BAR; }
        E(acc, cur, wr, wc, fr, fq);
        if (!has_next) break;
#pragma unroll
        for (int a = 0; a < 2; ++a)
#pragma unroll
            for (int b = 0; b < 2; ++b)
#pragma unroll
                for (int m = 0; m < 4; ++m)
#pragma unroll
                    for (int n = 0; n < 2; ++n) acc[a][b][m][n] = (f32x4){0.f, 0.f, 0.f, 0.f};
        cur = nxt; cA = nA; cB = nB; ++ui;
        if constexpr (ALIGN_EPI) { if (wr == 1) PG8_BAR; }
    }
    PG8_WAIT_V(0);
    if constexpr (!ALIGN_EPI) { if (wr == 0) PG8_BAR; }
    PG8_BAR;
#undef PG8_SA
#undef PG8_SB
#undef PG8_STAGE
#undef PG8_LDA
#undef PG8_LDB
#undef PG8_MMA
#undef PG8_WAIT_V
#undef PG8_WAIT_L
#undef PG8_BAR
#undef PG8_SCHED
}
}

__device__ __forceinline__ float silu_f(float v) { return v * __builtin_amdgcn_rcpf(1.f + __expf(-v)); }
__device__ __forceinline__ float gelu_tanh_f(float v) { const float u = 0.7978845608f * (v + 0.044715f * v * v * v); const float t = __expf(2.f * u); const float th = 1.f - 2.f * __builtin_amdgcn_rcpf(t + 1.f); return 0.5f * v * (1.f + th); }

struct EpiSwiglu {
    static constexpr bool PERM = true;
    unsigned char* ws;
    __device__ __forceinline__ void operator()(const f32x4 (&acc)[2][2][4][2], const pg8::Unit& u, int wr, int wc, int fr, int fq) const {
        bf16_t* A2 = (bf16_t*)(ws + WS_A2);
        const int row0 = u.pm * 256 + wr * 64 + fr, col0 = u.pn * 128 + wc * 32 + 8 * fq;
#pragma unroll
        for (int ai = 0; ai < 2; ++ai)
#pragma unroll
            for (int m = 0; m < 4; ++m) {
                const f32x4 g0 = acc[ai][0][m][0], g1 = acc[ai][0][m][1], u0 = acc[ai][1][m][0], u1 = acc[ai][1][m][1];
                u32x4 w;
                w.x = cvt_pk_bf16(silu_f(g0[0]) * u0[0], silu_f(g0[1]) * u0[1]); w.y = cvt_pk_bf16(silu_f(g0[2]) * u0[2], silu_f(g0[3]) * u0[3]);
                w.z = cvt_pk_bf16(silu_f(g1[0]) * u1[0], silu_f(g1[1]) * u1[1]); w.w = cvt_pk_bf16(silu_f(g1[2]) * u1[2], silu_f(g1[3]) * u1[3]);
                *(u32x4*)(A2 + (size_t)(row0 + ai * 128 + m * 16) * FF + col0) = w;
            }
    }
};
struct EpiF32 {
    static constexpr bool PERM = true;
    unsigned char* ws;
    __device__ __forceinline__ void operator()(const f32x4 (&acc)[2][2][4][2], const pg8::Unit& u, int wr, int wc, int fr, int fq) const {
        bf16_t* base = (bf16_t*)(ws + WS_Y) + (size_t)u.ks * MTOK * DM + (size_t)(u.pm * 256 + wr * 64 + fr) * DM + u.pn * 256 + wc * 32 + 8 * fq;
#pragma unroll
        for (int ai = 0; ai < 2; ++ai)
#pragma unroll
            for (int m = 0; m < 4; ++m)
#pragma unroll
                for (int bj = 0; bj < 2; ++bj) { const f32x4 v0 = acc[ai][bj][m][0], v1 = acc[ai][bj][m][1];
                    u32x4 w; w.x = cvt_pk_bf16(v0[0], v0[1]); w.y = cvt_pk_bf16(v0[2], v0[3]); w.z = cvt_pk_bf16(v1[0], v1[1]); w.w = cvt_pk_bf16(v1[2], v1[3]);
                    *(u32x4*)(base + (size_t)(ai * 128 + m * 16) * DM + bj * 128) = w; }
    }
};
struct EpiMixIn {
    static constexpr bool PERM = true;
    unsigned char* ws; float* out; int l;
    __device__ __forceinline__ void operator()(const f32x4 (&acc)[2][2][4][2], const pg8::Unit& u, int wr, int wc, int fr, int fq) const {
        bf16_t* Qb = (bf16_t*)(ws + WS_Q); bf16_t* Kb = (bf16_t*)(ws + WS_K); bf16_t* VT = (bf16_t*)(ws + WS_VT); bf16_t* TT = (bf16_t*)(ws + WS_TT); bf16_t* Gb = (bf16_t*)(ws + WS_G);
        float* newk = out + (size_t)MTOK * DM; float* newv = newk + (size_t)16 * 4 * 256 * 512;
        const int pn = u.pn;
        const bool prompt = u.pm < 16;
#pragma unroll
        for (int ai = 0; ai < 2; ++ai)
#pragma unroll
            for (int m = 0; m < 4; ++m) {
                const int row = u.pm * 256 + ai * 128 + wr * 64 + m * 16 + fr;
                const int bb = prompt ? (row >> 8) : ((row - MPR) >> 10), tt = prompt ? (row & 255) : ((row - MPR) & 1023);
#pragma unroll
                for (int bj = 0; bj < 2; ++bj) {
                    const int ct = bj * 128 + wc * 32 + 8 * fq;
                    f32x4 v0 = acc[ai][bj][m][0], v1 = acc[ai][bj][m][1];
                    if (pn < 2) {
                        v0 = v0 * 0.125f; v1 = v1 * 0.125f; u32x4 w; w.x = cvt_pk_bf16(v0[0], v0[1]); w.y = cvt_pk_bf16(v0[2], v0[3]); w.z = cvt_pk_bf16(v1[0], v1[1]); w.w = cvt_pk_bf16(v1[2], v1[3]);
                        *(u32x4*)(Qb + (size_t)row * 512 + pn * 256 + ct) = w;
                    } else if (pn < 4) {
                        const int c0 = (pn - 2) * 256 + ct;
                        u32x4 w; w.x = cvt_pk_bf16(v0[0], v0[1]); w.y = cvt_pk_bf16(v0[2], v0[3]); w.z = cvt_pk_bf16(v1[0], v1[1]); w.w = cvt_pk_bf16(v1[2], v1[3]);
                        { const int hd = c0 >> 6, dd = c0 & 63;
                          bf16_t* kd = prompt ? Kb + ((size_t)((bb * 8 + hd) * 256 + tt)) * 64 + dd : Kb + 2097152 + ((size_t)((bb * 8 + hd) * 1024 + tt)) * 64 + dd;
                          *(u32x4*)kd = w; }
                        if (prompt) { float* o = newk + ((size_t)(bb * 4 + l) * 256 + tt) * 512 + c0; __builtin_nontemporal_store(v0, (f32x4*)o); __builtin_nontemporal_store(v1, (f32x4*)(o + 4)); }
                    } else if (pn < 6) {
                        const int c0 = (pn - 4) * 256 + ct;
                        if (prompt) { float* o = newv + ((size_t)(bb * 4 + l) * 256 + tt) * 512 + c0; __builtin_nontemporal_store(v0, (f32x4*)o); __builtin_nontemporal_store(v1, (f32x4*)(o + 4)); }
                        const int hd = c0 >> 6, dd = c0 & 63;
                        bf16_t* vt = prompt ? VT + ((size_t)((bb * 8 + hd) * 8 + (tt >> 5))) * 2048 + dd * 32 + (tt & 31) : VT + 2097152 + ((size_t)((bb * 8 + hd) * 16 + (tt >> 6))) * 4096 + dd * 64 + (tt & 63);
                        const size_t vp = prompt ? 32 : 64;
#pragma unroll
                        for (int i = 0; i < 4; ++i) { vt[(size_t)i * vp] = (bf16_t)(cvt_pk_bf16(v0[i], v0[i]) & 0xffffu); vt[(size_t)(i + 4) * vp] = (bf16_t)(cvt_pk_bf16(v1[i], v1[i]) & 0xffffu); }
                    } else if (pn < 8) {
                        const int half = pn - 6;
                        bf16_t* t = prompt ? TT + ((size_t)(bb * 256 + ct) * 512 + half * 256 + tt) : TT + 2097152 + ((size_t)(bb * 256 + ct) * 2048 + half * 1024 + tt);
                        const size_t tp = prompt ? 512 : 2048;
#pragma unroll
                        for (int i = 0; i < 4; ++i) { t[(size_t)i * tp] = (bf16_t)(cvt_pk_bf16(v0[i], v0[i]) & 0xffffu); t[(size_t)(i + 4) * tp] = (bf16_t)(cvt_pk_bf16(v1[i], v1[i]) & 0xffffu); }
                    } else {
                        u32x4 w; w.x = cvt_pk_bf16(gelu_tanh_f(v0[0]), gelu_tanh_f(v0[1])); w.y = cvt_pk_bf16(gelu_tanh_f(v0[2]), gelu_tanh_f(v0[3]));
                        w.z = cvt_pk_bf16(gelu_tanh_f(v1[0]), gelu_tanh_f(v1[1])); w.w = cvt_pk_bf16(gelu_tanh_f(v1[2]), gelu_tanh_f(v1[3]));
                        *(u32x4*)(Gb + (size_t)row * 512 + (pn - 8) * 256 + ct) = w;
                    }
                }
            }
    }
};
struct EpiFourier {
    static constexpr bool PERM = true;
    unsigned char* ws; int row0, rpb_;
    __device__ __forceinline__ void operator()(const f32x4 (&acc)[2][2][4][2], const pg8::Unit& u, int wr, int wc, int fr, int fq) const {
        bf16_t* O = (bf16_t*)(ws + WS_O);
        const int rowb = row0 + u.pn * rpb_ + u.pm * 256 + wr * 64 + fr;
#pragma unroll
        for (int ai = 0; ai < 2; ++ai)
#pragma unroll
            for (int m = 0; m < 4; ++m)
#pragma unroll
                for (int bj = 0; bj < 2; ++bj) {
                    const f32x4 v0 = acc[ai][bj][m][0], v1 = acc[ai][bj][m][1];
                    u32x4 w; w.x = cvt_pk_bf16(v0[0], v0[1]); w.y = cvt_pk_bf16(v0[2], v0[3]); w.z = cvt_pk_bf16(v1[0], v1[1]); w.w = cvt_pk_bf16(v1[2], v1[3]);
                    *(u32x4*)(O + (size_t)(rowb + ai * 128 + m * 16) * DM + 512 + bj * 128 + wc * 32 + 8 * fq) = w;
                }
    }
};

__device__ __forceinline__ void transpose_item(const float* W, int ldw, int k0, int n0, bf16_t* WT, int ldt, int drow0, LAS float* scr, int lane) {
    float v[32];
    const float* src = W + (size_t)(k0 + (lane >> 5)) * ldw + n0 + (lane & 31);
#pragma unroll
    for (int i = 0; i < 32; ++i) v[i] = __builtin_nontemporal_load(src + (size_t)(2 * i) * ldw);
#pragma unroll
    for (int i = 0; i < 32; ++i) scr[(2 * i + (lane >> 5)) * 33 + (lane & 31)] = v[i];
    LDS_WAIT(); asm volatile("" ::: "memory");
    const int c = lane & 7;
#pragma unroll
    for (int j = 0; j < 4; ++j) { const int n = (lane >> 3) + 8 * j; const LAS float* s = scr + (8 * c) * 33 + n;
        u32x4 o; o.x = cvt_pk_bf16(s[0 * 33], s[1 * 33]); o.y = cvt_pk_bf16(s[2 * 33], s[3 * 33]); o.z = cvt_pk_bf16(s[4 * 33], s[5 * 33]); o.w = cvt_pk_bf16(s[6 * 33], s[7 * 33]);
        *(u32x4*)(WT + (size_t)(drow0 + n) * ldt + k0 + 8 * c) = o; }
    LDS_WAIT(); asm volatile("" ::: "memory");
}

__device__ __forceinline__ void mod_items(const Params& p, LAS unsigned char* lds, int l, int first, int stride) {
    const int tid = opaque_tid(), lane = tid & 63, wave = __builtin_amdgcn_readfirstlane(tid >> 6);
    if (first >= 64) return;
    LAS float* sc = (LAS float*)lds;
    LAS float* red = (LAS float*)(lds + 20480);
    for (int i = tid; i < 5 * 1024; i += NTHR) { const int mi = i >> 10, k = i & 1023; const float v = mi == 0 ? p.c_ctx[k] : p.c[(mi - 1) * 1024 + k]; sc[i] = v / (1.f + __expf(-v)); }
    __syncthreads();
    float* mod = (float*)(p.ws + WS_MOD);
    for (int item = first; item < 64; item += stride) {
        const int n0 = item * 144;
        const int ln = lane < 36 ? lane : 35;
        const float* wp = p.ada_w + ((size_t)l * 1024 + wave * 128) * 9216 + n0 + ln * 4;
        f32x4 a0 = {0.f, 0.f, 0.f, 0.f}, a1 = a0, a2 = a0, a3 = a0, a4 = a0;
#pragma unroll 16
        for (int k = 0; k < 128; ++k) { const f32x4 w = __builtin_nontemporal_load((const f32x4*)(wp + (size_t)k * 9216)); const int kk = wave * 128 + k;
            a0 += w * sc[kk]; a1 += w * sc[1024 + kk]; a2 += w * sc[2048 + kk]; a3 += w * sc[3072 + kk]; a4 += w * sc[4096 + kk]; }
        if (lane < 36) {
            *(LAS f32x4*)(red + (wave * 5 + 0) * 144 + lane * 4) = a0; *(LAS f32x4*)(red + (wave * 5 + 1) * 144 + lane * 4) = a1; *(LAS f32x4*)(red + (wave * 5 + 2) * 144 + lane * 4) = a2;
            *(LAS f32x4*)(red + (wave * 5 + 3) * 144 + lane * 4) = a3; *(LAS f32x4*)(red + (wave * 5 + 4) * 144 + lane * 4) = a4; }
        __syncthreads();
        for (int o = tid; o < 720; o += NTHR) { const int mi = o / 144, cc = o % 144; float sum = 0.f;
#pragma unroll
            for (int w = 0; w < 8; ++w) sum += red[(w * 5 + mi) * 144 + cc];
            const int n = n0 + cc; mod[(size_t)(l * 5 + mi) * 9216 + n] = sum + p.ada_b[l * 9216 + n]; }
        __syncthreads();
    }
}
__device__ __forceinline__ void fwi0_items(const Params& p, LAS unsigned char* lds, int l, int sfx, int first, int stride) {
    const int tid = opaque_tid(), lane = tid & 63, wave = __builtin_amdgcn_readfirstlane(tid >> 6);
    LAS float* scr = (LAS float*)(lds + wave * 8704);
    unsigned char* wl = p.ws + WS_W + (size_t)l * W_LAYER;
    constexpr int NIT = 16 * 176 + 44 * 32;
    const int f0 = first + wave; if (f0 >= NIT) return;
    const int nmine = (NIT - 1 - f0) / stride + 1;
#define FW_DEC(j_, S_, LDW_, D_, LDT_) do { int r_ = f0 + (j_) * stride; \
        if (r_ < 16 * 176) { const int kb_ = r_ / 176, n0_ = (r_ % 176) * 32; \
            const int drow_ = n0_ < FF ? (n0_ >> 7) * 256 + (n0_ & 127) : ((n0_ - FF) >> 7) * 256 + 128 + ((n0_ - FF) & 127); \
            S_ = p.ffn_w_in + (size_t)(l * 2 + sfx) * 1024 * NFI + (size_t)(kb_ * 64 + (lane >> 5)) * NFI + n0_ + (lane & 31); LDW_ = NFI; \
            D_ = (bf16_t*)(wl + W_FWI + sfx * SZ_FWI) + (size_t)drow_ * 1024 + kb_ * 64; LDT_ = 1024; } \
        else { r_ -= 16 * 176; const int kb_ = r_ / 32, nb_ = r_ % 32; \
            S_ = p.ffn_w_out + (size_t)(l * 2 + sfx) * FF * 1024 + (size_t)(kb_ * 64 + (lane >> 5)) * 1024 + nb_ * 32 + (lane & 31); LDW_ = 1024; \
            D_ = (bf16_t*)(wl + W_FWO + sfx * SZ_FWO) + (size_t)(nb_ * 32) * FF + kb_ * 64; LDT_ = FF; } } while (0)
#define FW_LOAD(S_, LDW_, V) do { _Pragma("unroll") for (int i = 0; i < 32; ++i) V[i] = __builtin_nontemporal_load((S_) + (size_t)(2 * i) * (LDW_)); } while (0)
#define FW_STORE(D_, LDT_, V) do { _Pragma("unroll") for (int i = 0; i < 32; ++i) scr[(2 * i + (lane >> 5)) * 33 + (lane & 31)] = V[i]; \
        LDS_WAIT(); asm volatile("" ::: "memory"); const int c_ = lane & 7; \
        _Pragma("unroll") for (int j_ = 0; j_ < 4; ++j_) { const int n_ = (lane >> 3) + 8 * j_; const LAS float* q_ = scr + (8 * c_) * 33 + n_; \
            u32x4 o_; o_.x = cvt_pk_bf16(q_[0 * 33], q_[1 * 33]); o_.y = cvt_pk_bf16(q_[2 * 33], q_[3 * 33]); o_.z = cvt_pk_bf16(q_[4 * 33], q_[5 * 33]); o_.w = cvt_pk_bf16(q_[6 * 33], q_[7 * 33]); \
            *(u32x4*)((D_) + (size_t)n_ * (LDT_) + 8 * c_) = o_; } \
        LDS_WAIT(); asm volatile("" ::: "memory"); } while (0)
    const float* sA; bf16_t* dA; int wA_, tA_; const float* sB; bf16_t* dB; int wB_, tB_; float va[32], vb[32];
    FW_DEC(0, sA, wA_, dA, tA_); FW_LOAD(sA, wA_, va);
#pragma unroll 1
    for (int j = 0; j < nmine; j += 2) {
        FW_DEC(min(j + 1, nmine - 1), sB, wB_, dB, tB_); FW_LOAD(sB, wB_, vb);
        FW_STORE(dA, tA_, va);
        FW_DEC(min(j + 2, nmine - 1), sA, wA_, dA, tA_); FW_LOAD(sA, wA_, va);
        if (j + 1 < nmine) FW_STORE(dB, tB_, vb);
    }
#undef FW_DEC
#undef FW_LOAD
#undef FW_STORE
}

__device__ __forceinline__ void prologue(const Params& p, LAS unsigned char* lds, int G) {
    const int tid = opaque_tid(), lane = tid & 63, wave = __builtin_amdgcn_readfirstlane(tid >> 6);
    const int bx = blockIdx.x;
    unsigned char* ws = p.ws;
    mod_items(p, lds, bx >> 6, bx & 63, 64);
    LAS float* tabc = (LAS float*)(lds + 73728); LAS float* tabs = (LAS float*)(lds + 90112);
    for (int i = tid; i < 4096; i += NTHR) { const int j = ((i >> 6) * (i & 63)) & 63; tabc[i] = cospif((float)j * (1.f / 32.f)) * 0.125f; tabs[i] = sinpif((float)j * (1.f / 32.f)) * 0.125f; }
    __syncthreads();
    const int gw = bx * NWAVES + wave, NGW = G * NWAVES;
    LAS float* scr = (LAS float*)(lds + wave * 8704);
    for (int it = gw; it < NLAYER * 64 * 8; it += NGW) {
        const int l = it >> 9, r = (it >> 3) & 63, cq = it & 7;
        unsigned char* wl = ws + WS_W + (size_t)l * W_LAYER;
        const int kb = r >> 2, g = r & 3, k = kb * 64 + lane;
        const float* src = p.w_in + ((size_t)l * 1024 + k) * 2304 + 1536 + g * 64;
        f32x4 w[16];
#pragma unroll
        for (int i = 0; i < 16; ++i) w[i] = *(const f32x4*)(src + 4 * i);
        bf16_t* d1 = (bf16_t*)(wl + W_WIN) + (size_t)(1536 + g * 64) * 1024 + k; bf16_t* d2 = d1 + (size_t)256 * 1024;
        for (int cp = cq * 8; cp < cq * 8 + 8; ++cp) {
            float t1 = 0.f, t2 = 0.f;
#pragma unroll
            for (int c4 = 0; c4 < 16; ++c4) { const f32x4 tc = *(const LAS f32x4*)(tabc + cp * 64 + 4 * c4), ts = *(const LAS f32x4*)(tabs + cp * 64 + 4 * c4); const f32x4 wv = w[c4];
                t1 += (wv[0] * tc[0] + wv[1] * tc[1]) + (wv[2] * tc[2] + wv[3] * tc[3]); t2 += (wv[0] * ts[0] + wv[1] * ts[1]) + (wv[2] * ts[2] + wv[3] * ts[3]); }
            d1[(size_t)cp * 1024] = (bf16_t)(cvt_pk_bf16(t1, t1) & 0xffffu); d2[(size_t)cp * 1024] = (bf16_t)(cvt_pk_bf16(t2, t2) & 0xffffu);
        }
    }
    constexpr int I_FWI = 16 * 176, I_FWO = 44 * 32, I_QKV = 16 * 48, I_G = 16 * 16, I_WO = 16 * 32;
    constexpr int I_REST = 2 * I_FWO + I_QKV + I_G + I_WO, I_REST3 = I_QKV + I_G + I_WO, I_L0 = I_FWI + I_FWO + I_REST3, I_ALL = I_L0 + 3 * I_REST3;
#define TR_DECODE(it_, SRC, LDW, DST, LDT) do { int r_ = (it_), l_ = 0; \
        if (r_ >= I_L0) { r_ -= I_L0; l_ = 1 + r_ / I_REST3; r_ = r_ % I_REST3 + 2 * I_FWI + 2 * I_FWO; } \
        else if (r_ >= I_FWI + I_FWO) r_ += I_FWI + I_FWO; else if (r_ >= I_FWI) r_ += I_FWI; \
        unsigned char* wl_ = ws + WS_W + (size_t)l_ * W_LAYER; \
        if (r_ < 2 * I_FWI) { const int s_ = r_ / I_FWI; r_ %= I_FWI; const int kb_ = r_ / 176, n0_ = (r_ % 176) * 32; \
            const int drow_ = n0_ < FF ? (n0_ >> 7) * 256 + (n0_ & 127) : ((n0_ - FF) >> 7) * 256 + 128 + ((n0_ - FF) & 127); \
            SRC = p.ffn_w_in + (size_t)(l_ * 2 + s_) * 1024 * NFI + (size_t)(kb_ * 64) * NFI + n0_; LDW = NFI; DST = (bf16_t*)(wl_ + W_FWI + s_ * SZ_FWI) + (size_t)drow_ * 1024 + kb_ * 64; LDT = 1024; } \
        else { r_ -= 2 * I_FWI; \
          if (r_ < 2 * I_FWO) { const int s_ = r_ / I_FWO; r_ %= I_FWO; const int kb_ = r_ / 32, nb_ = r_ % 32; \
            SRC = p.ffn_w_out + (size_t)(l_ * 2 + s_) * FF * 1024 + (size_t)(kb_ * 64) * 1024 + nb_ * 32; LDW = 1024; DST = (bf16_t*)(wl_ + W_FWO + s_ * SZ_FWO) + (size_t)(nb_ * 32) * FF + kb_ * 64; LDT = FF; } \
          else { r_ -= 2 * I_FWO; \
            if (r_ < I_QKV) { const int kb_ = r_ / 48, nb_ = r_ % 48; SRC = p.w_in + (size_t)l_ * 1024 * 2304 + (size_t)(kb_ * 64) * 2304 + nb_ * 32; LDW = 2304; DST = (bf16_t*)(wl_ + W_WIN) + (size_t)(nb_ * 32) * 1024 + kb_ * 64; LDT = 1024; } \
            else { r_ -= I_QKV; \
              if (r_ < I_G) { const int kb_ = r_ / 16, nb_ = r_ % 16; SRC = p.w_in + (size_t)l_ * 1024 * 2304 + (size_t)(kb_ * 64) * 2304 + 1792 + nb_ * 32; LDW = 2304; DST = (bf16_t*)(wl_ + W_WIN) + (size_t)(2048 + nb_ * 32) * 1024 + kb_ * 64; LDT = 1024; } \
              else { r_ -= I_G; const int kb_ = r_ / 32, nb_ = r_ % 32; SRC = p.w_out + (size_t)l_ * 1024 * 1024 + (size_t)(kb_ * 64) * 1024 + nb_ * 32; LDW = 1024; DST = (bf16_t*)(wl_ + W_WOUT) + (size_t)(nb_ * 32) * 1024 + kb_ * 64; LDT = 1024; } } } } } while (0)
#define TR_LOAD(SRC, LDW, V) do { const float* s_ = (SRC) + (size_t)(lane >> 5) * (LDW) + (lane & 31); _Pragma("unroll") for (int i = 0; i < 32; ++i) V[i] = __builtin_nontemporal_load(s_ + (size_t)(2 * i) * (LDW)); } while (0)
#define TR_STORE(DST, LDT, V) do { _Pragma("unroll") for (int i = 0; i < 32; ++i) scr[(2 * i + (lane >> 5)) * 33 + (lane & 31)] = V[i]; \
        LDS_WAIT(); asm volatile("" ::: "memory"); const int c_ = lane & 7; \
        _Pragma("unroll") for (int j = 0; j < 4; ++j) { const int n_ = (lane >> 3) + 8 * j; const LAS float* q_ = scr + (8 * c_) * 33 + n_; \
            u32x4 o_; o_.x = cvt_pk_bf16(q_[0 * 33], q_[1 * 33]); o_.y = cvt_pk_bf16(q_[2 * 33], q_[3 * 33]); o_.z = cvt_pk_bf16(q_[4 * 33], q_[5 * 33]); o_.w = cvt_pk_bf16(q_[6 * 33], q_[7 * 33]); \
            *(u32x4*)((DST) + (size_t)n_ * (LDT) + 8 * c_) = o_; } \
        LDS_WAIT(); asm volatile("" ::: "memory"); } while (0)
    if (gw < I_ALL) {
        const int nmine = (I_ALL - 1 - gw) / NGW + 1;
        const float* sA; int ldwA; bf16_t* dA; int ldtA; const float* sB; int ldwB; bf16_t* dB; int ldtB;
        float va[32], vb[32];
        TR_DECODE(gw, sA, ldwA, dA, ldtA); TR_LOAD(sA, ldwA, va);
#pragma unroll 1
        for (int j = 0; j < nmine; j += 2) {
            { const int jn = min(j + 1, nmine - 1); TR_DECODE(gw + jn * NGW, sB, ldwB, dB, ldtB); TR_LOAD(sB, ldwB, vb); }
            TR_STORE(dA, ldtA, va);
            { const int jn = min(j + 2, nmine - 1); TR_DECODE(gw + jn * NGW, sA, ldwA, dA, ldtA); TR_LOAD(sA, ldwA, va); }
            if (j + 1 < nmine) TR_STORE(dB, ldtB, vb);
        }
    }
#undef TR_DECODE
#undef TR_LOAD
#undef TR_STORE
    const int gt = bx * NTHR + tid, NGT = G * NTHR;
    {   bf16_t* dfts = (bf16_t*)(ws + WS_DFTS);
        for (int e = gt; e < 1024 * 2048 / 8; e += NGT) { const int np = e >> 8, k0 = (e & 255) * 8; float v[8];
#pragma unroll
            for (int i = 0; i < 8; ++i) { const int k = k0 + i; const int j = (np * (k & 1023)) & 1023; const float a = (float)j * (1.f / 512.f); v[i] = (k < 1024 ? cospif(a) : -sinpif(a)) * 0.03125f; }
            u32x4 w; w.x = cvt_pk_bf16(v[0], v[1]); w.y = cvt_pk_bf16(v[2], v[3]); w.z = cvt_pk_bf16(v[4], v[5]); w.w = cvt_pk_bf16(v[6], v[7]); *(u32x4*)(dfts + (size_t)e * 8) = w; }
        bf16_t* dftp = (bf16_t*)(ws + WS_DFTP);
        for (int e = gt; e < 256 * 512 / 8; e += NGT) { const int np = e >> 6, k0 = (e & 63) * 8; float v[8];
#pragma unroll
            for (int i = 0; i < 8; ++i) { const int k = k0 + i; const int j = (np * (k & 255)) & 255; const float a = (float)j * (1.f / 128.f); v[i] = (k < 256 ? cospif(a) : -sinpif(a)) * 0.0625f; }
            u32x4 w; w.x = cvt_pk_bf16(v[0], v[1]); w.y = cvt_pk_bf16(v[2], v[3]); w.z = cvt_pk_bf16(v[4], v[5]); w.w = cvt_pk_bf16(v[6], v[7]); *(u32x4*)(dftp + (size_t)e * 8) = w; }
        bf16_t* gw16 = (bf16_t*)(ws + WS_GW);
        for (int e = gt; e < 4 * 4 * 128 * 128 / 8; e += NGT) { const float* sp = p.gmlp_w + (size_t)e * 8; const f32x4 v0 = *(const f32x4*)sp, v1 = *(const f32x4*)(sp + 4);
            u32x4 w; w.x = cvt_pk_bf16(v0[0], v0[1]); w.y = cvt_pk_bf16(v0[2], v0[3]); w.z = cvt_pk_bf16(v1[0], v1[1]); w.w = cvt_pk_bf16(v1[2], v1[3]); *(u32x4*)(gw16 + (size_t)e * 8) = w; }
        bf16_t* ck = (bf16_t*)(ws + WS_CK);
        for (int e = gt; e < 4 * 4 * 8 * 256 * 8; e += NGT) { const int d8 = (e & 7) * 8, pp_ = (e >> 3) & 255, h = (e >> 11) & 7, b = (e >> 14) & 3, l = e >> 16;
            const float* sp = p.cache_k + ((size_t)((b * 4 + l) * 256 + pp_)) * 512 + h * 64 + d8; const f32x4 v0 = *(const f32x4*)sp, v1 = *(const f32x4*)(sp + 4);
            u32x4 w; w.x = cvt_pk_bf16(v0[0], v0[1]); w.y = cvt_pk_bf16(v0[2], v0[3]); w.z = cvt_pk_bf16(v1[0], v1[1]); w.w = cvt_pk_bf16(v1[2], v1[3]); *(u32x4*)(ck + (size_t)e * 8) = w; }
        bf16_t* cvt = (bf16_t*)(ws + WS_CVT);
        for (int e = gt; e < 4 * 4 * 8 * 8 * 64 * 4; e += NGT) { const int pg = e & 3, d = (e >> 2) & 63, chk = (e >> 8) & 7, h = (e >> 11) & 7, b = (e >> 14) & 3, l = e >> 16;
            const float* sp = p.cache_v + ((size_t)((b * 4 + l) * 256 + chk * 32 + pg * 8)) * 512 + h * 64 + d; float v[8];
#pragma unroll
            for (int i = 0; i < 8; ++i) v[i] = sp[(size_t)i * 512];
            u32x4 w; w.x = cvt_pk_bf16(v[0], v[1]); w.y = cvt_pk_bf16(v[2], v[3]); w.z = cvt_pk_bf16(v[4], v[5]); w.w = cvt_pk_bf16(v[6], v[7]);
            *(u32x4*)(cvt + (size_t)e * 8) = w; }
    }
}

__device__ __forceinline__ void norm_phase(const Params& p, int G, bool first, bool has_prev, bool has_next, float coef, bool dummy,
                                           const float* modp_gate  , const float* npost, const float* modn  , const float* npre) {
    const int tid = opaque_tid(), lane = tid & 63, wave = tid >> 6;
    const int gw = opaque_bx() * NWAVES + wave, NGW = G * NWAVES;
    const float* X = p.out; float* Xo = dummy ? (float*)(p.ws + WS_END) : p.out; const bf16_t* Y0 = (const bf16_t*)(p.ws + WS_Y); const bf16_t* Y1 = Y0 + (size_t)MTOK * DM; bf16_t* H = dummy ? (bf16_t*)(p.ws + WS_END + 32 * MiB) : (bf16_t*)(p.ws + WS_H);
    for (int row = gw; row < MTOK; row += NGW) {
        const int mi = row < MPR ? 0 : 1 + ((row - MPR) >> 10);
        const float* xs = first ? (row < MPR ? p.x_prompt + (size_t)row * DM : p.x_sample + (size_t)(row - MPR) * DM) : X + (size_t)row * DM;
        f32x4 x[4], gt[4], npo[4], sh[4], scl[4], npr[4]; u32x2 ya[4], yb[4];
#pragma unroll
        for (int j = 0; j < 4; ++j) x[j] = *(const f32x4*)(xs + 4 * lane + 256 * j);
        if (has_prev) {
#pragma unroll
            for (int j = 0; j < 4; ++j) { ya[j] = *(const u32x2*)(Y0 + (size_t)row * DM + 4 * lane + 256 * j); yb[j] = *(const u32x2*)(Y1 + (size_t)row * DM + 4 * lane + 256 * j);
                gt[j] = *(const f32x4*)(modp_gate + (size_t)mi * 9216 + 4 * lane + 256 * j); npo[j] = *(const f32x4*)(npost + 4 * lane + 256 * j); }
        }
        if (has_next) {
#pragma unroll
            for (int j = 0; j < 4; ++j) { sh[j] = *(const f32x4*)(modn + (size_t)mi * 9216 + 4 * lane + 256 * j); scl[j] = *(const f32x4*)(modn + (size_t)mi * 9216 + 1024 + 4 * lane + 256 * j);
                npr[j] = *(const f32x4*)(npre + 4 * lane + 256 * j); }
        }
        if (has_prev) {
            f32x4 y[4]; float ss = 0.f;
#pragma unroll
            for (int j = 0; j < 4; ++j) {
                y[j][0] = __uint_as_float(ya[j].x << 16) + __uint_as_float(yb[j].x << 16); y[j][1] = __uint_as_float(ya[j].x & 0xffff0000u) + __uint_as_float(yb[j].x & 0xffff0000u);
                y[j][2] = __uint_as_float(ya[j].y << 16) + __uint_as_float(yb[j].y << 16); y[j][3] = __uint_as_float(ya[j].y & 0xffff0000u) + __uint_as_float(yb[j].y & 0xffff0000u);
                ss += (y[j][0] * y[j][0] + y[j][1] * y[j][1]) + (y[j][2] * y[j][2] + y[j][3] * y[j][3]); }
            const float rs = coef * rsqrtf(wave_sum(ss) * (1.f / DM) + EPS);
#pragma unroll
            for (int j = 0; j < 4; ++j) x[j] += gt[j] * (y[j] * rs * npo[j]);
        }
        u32x2 hw[4];
        if (has_next) {
            float ss = 0.f;
#pragma unroll
            for (int j = 0; j < 4; ++j) ss += (x[j][0] * x[j][0] + x[j][1] * x[j][1]) + (x[j][2] * x[j][2] + x[j][3] * x[j][3]);
            const float rs = rsqrtf(wave_sum(ss) * (1.f / DM) + EPS);
#pragma unroll
            for (int j = 0; j < 4; ++j) { const f32x4 h = (x[j] * rs * npr[j]) * (scl[j] + 1.f) + sh[j]; hw[j].x = cvt_pk_bf16(h[0], h[1]); hw[j].y = cvt_pk_bf16(h[2], h[3]); }
        }
        if (has_prev || first) {
#pragma unroll
            for (int j = 0; j < 4; ++j) *(f32x4*)(Xo + (size_t)row * DM + 4 * lane + 256 * j) = x[j];
        }
        if (has_next) {
#pragma unroll
            for (int j = 0; j < 4; ++j) *(u32x2*)(H + (size_t)row * DM + 4 * lane + 256 * j) = hw[j];
        }
    }
}

#define MFMA16(a, b, c) __builtin_amdgcn_mfma_f32_16x16x32_bf16(a, b, c, 0, 0, 0)
struct AttnCtx { const bf16_t *Kb, *VT, *CKl, *CVTl; int nbr, bh, rlo, nloc, cb, ka, fr, fq; };
__device__ __forceinline__ void attn_load(const AttnCtx& c, int ch, bf16x8 (&kf)[4], bf16x8 (&vf)[4]) {
    const bf16_t* kbase; const bf16_t* vbase; int vpitch;
    if (c.nbr) {
        if (ch < c.nloc) { const int arow = c.rlo + ch; kbase = c.Kb + 2097152 + (size_t)(c.bh * 1024 + arow * 64 + c.cb) * 64; vbase = c.VT + 2097152 + (size_t)(c.bh * 16 + arow) * 4096 + c.cb; vpitch = 64; }
        else { const int cc = min(ch - c.nloc, 7); kbase = c.CKl + (size_t)(c.bh * 256 + cc * 32) * 64; vbase = c.CVTl + (size_t)(c.bh * 8 + cc) * 2048; vpitch = 32; }
    } else { kbase = c.Kb + (size_t)(c.bh * 256 + ch * 32) * 64; vbase = c.VT + (size_t)(c.bh * 8 + ch) * 2048; vpitch = 32; }
    const bf16_t* kp0 = kbase + (size_t)c.ka * 64 + c.fq * 8; const bf16_t* kp1 = kp0 + 4 * 64;
    kf[0] = *(const bf16x8*)kp0; kf[1] = *(const bf16x8*)(kp0 + 32); kf[2] = *(const bf16x8*)kp1; kf[3] = *(const bf16x8*)(kp1 + 32);
#pragma unroll
    for (int dt = 0; dt < 4; ++dt) vf[dt] = *(const bf16x8*)(vbase + (size_t)(dt * 16 + c.fr) * vpitch + c.fq * 8);
}
struct AttnTile { bf16x8 q0, q1; f32x4 o[4]; float m, l; };
__device__ __forceinline__ void attn_step(AttnTile& t, const bf16x8 (&kf)[4], const bf16x8 (&vf)[4], bool local, const LAS float* brow, int kc0, int qc, int cs) {
    f32x4 s0 = {0.f, 0.f, 0.f, 0.f}, s1 = s0;
    s0 = MFMA16(kf[0], t.q0, s0); s0 = MFMA16(kf[1], t.q1, s0); s1 = MFMA16(kf[2], t.q0, s1); s1 = MFMA16(kf[3], t.q1, s1);
    float s[8] = {s0[0], s0[1], s0[2], s0[3], s1[0], s1[1], s1[2], s1[3]};
    if (local) {
        float bias[8];
#pragma unroll
        for (int i = 0; i < 8; ++i) { const int kc = kc0 + i; const bool valid = kc >= cs && kc < cs + 16; bias[i] = brow[valid ? kc : qc]; }
        asm volatile("" : "+v"(bias[0]), "+v"(bias[1]), "+v"(bias[2]), "+v"(bias[3]), "+v"(bias[4]), "+v"(bias[5]), "+v"(bias[6]), "+v"(bias[7]));
#pragma unroll
        for (int i = 0; i < 8; ++i) { const int kc = kc0 + i; const bool valid = kc >= cs && kc < cs + 16; s[i] = valid ? s[i] + bias[i] : -1e30f; }
    }
    float mx = fmaxf(fmaxf(fmaxf(s[0], s[1]), fmaxf(s[2], s[3])), fmaxf(fmaxf(s[4], s[5]), fmaxf(s[6], s[7])));
    mx = fmaxf(mx, __shfl_xor(mx, 16)); mx = fmaxf(mx, __shfl_xor(mx, 32));
    const float mnew = fmaxf(t.m, mx); const float alpha = __expf(t.m - mnew); t.m = mnew;
    float ps = 0.f;
#pragma unroll
    for (int i = 0; i < 8; ++i) { s[i] = __expf(s[i] - mnew); ps += s[i]; }
    t.l = t.l * alpha + ps;
    union { u32x4 w; bf16x8 v; } pb; pb.w.x = cvt_pk_bf16(s[0], s[1]); pb.w.y = cvt_pk_bf16(s[2], s[3]); pb.w.z = cvt_pk_bf16(s[4], s[5]); pb.w.w = cvt_pk_bf16(s[6], s[7]);
#pragma unroll
    for (int dt = 0; dt < 4; ++dt) { t.o[dt] = t.o[dt] * alpha; t.o[dt] = MFMA16(vf[dt], pb.v, t.o[dt]); }
}
struct AttnPair { int nbr, nloc, dB, cb, fq, qc, cs; const LAS float *btA, *btB; };
__device__ __forceinline__ void attn_step2(const AttnPair& P, int ch, AttnTile& A, AttnTile& B, const bf16x8 (&kf)[4], const bf16x8 (&vf)[4]) {
    const int kc0 = P.cb + P.fq * 8;
    if (P.nbr) {
        if (ch < P.nloc) {
            if (ch < 8) attn_step(A, kf, vf, true, P.btA + ch * 31 + 15 - P.qc, kc0, P.qc, P.cs);
            if (ch >= P.dB) attn_step(B, kf, vf, true, P.btB + (ch - P.dB) * 31 + 15 - P.qc, kc0, P.qc, P.cs);
        } else if (ch < P.nloc + 8) { attn_step(A, kf, vf, false, nullptr, kc0, P.qc, P.cs); attn_step(B, kf, vf, false, nullptr, kc0, P.qc, P.cs); }
    } else { attn_step(A, kf, vf, false, nullptr, kc0, P.qc, P.cs); attn_step(B, kf, vf, false, nullptr, kc0, P.qc, P.cs); }
}
__device__ __forceinline__ void attn_finish(AttnTile& t, bf16_t* op) {
    float ls = t.l; ls += __shfl_xor(ls, 16); ls += __shfl_xor(ls, 32);
    const float inv = __builtin_amdgcn_rcpf(ls);
#pragma unroll
    for (int dt = 0; dt < 4; ++dt) { u32x2 w; w.x = cvt_pk_bf16(t.o[dt][0] * inv, t.o[dt][1] * inv); w.y = cvt_pk_bf16(t.o[dt][2] * inv, t.o[dt][3] * inv); *(u32x2*)(op + dt * 16) = w; }
}
__device__ __forceinline__ void attn_wave_unit(int u2, int l, unsigned char* ws, const float* rpb, LAS unsigned char* wl, int lane) {
    const bf16_t* Qb = (const bf16_t*)(ws + WS_Q); bf16_t* O = (bf16_t*)(ws + WS_O);
    AttnCtx c; c.Kb = (const bf16_t*)(ws + WS_K); c.VT = (const bf16_t*)(ws + WS_VT);
    c.CKl = (const bf16_t*)(ws + WS_CK) + (size_t)l * 524288; c.CVTl = (const bf16_t*)(ws + WS_CVT) + (size_t)l * 524288;
    const int fr = lane & 15, fq = lane >> 4; c.fr = fr; c.fq = fq; c.ka = (fr >> 2) * 8 + (fr & 3);
    c.nbr = u2 < 1024;
    AttnPair P; P.nbr = c.nbr; P.fq = fq;
    int h, qrowA, qrowB, nch, rA = 0, rsA = 0, rsB = 0, jb = 0;
    if (c.nbr) { const int b = u2 >> 8; h = (u2 >> 5) & 7; const int rp = (u2 >> 2) & 7; jb = u2 & 3; c.bh = b * 8 + h; rA = 2 * rp;
        rsA = min(max(rA - 4, 0), 8); rsB = min(max(rA - 3, 0), 8); c.rlo = rsA; c.nloc = rsB - rsA + 8; c.cb = min(max(16 * jb - 8, 0), 32);
        qrowA = MPR + b * 1024 + rA * 64 + jb * 16; qrowB = qrowA + 64; nch = (c.nloc + 8 + 1) & ~1; }
    else { const int v = u2 - 1024; const int b = v >> 6; h = (v >> 3) & 7; c.bh = b * 8 + h; c.rlo = 0; c.nloc = 0; c.cb = 0; qrowA = b * 256 + (v & 7) * 32; qrowB = qrowA + 16; nch = 8; }
    P.nloc = c.nloc; P.dB = rsB - rsA; P.cb = c.cb; P.qc = jb * 16 + fr; P.cs = min(max(P.qc - 8, 0), 48);
    LAS float* btab = (LAS float*)wl;
    P.btA = btab; P.btB = btab + 256;
    AttnTile A, B;
    { const bf16_t* qa = Qb + (size_t)(qrowA + fr) * 512 + h * 64 + fq * 8; const bf16_t* qb = Qb + (size_t)(qrowB + fr) * 512 + h * 64 + fq * 8;
      A.q0 = *(const bf16x8*)qa; A.q1 = *(const bf16x8*)(qa + 32); B.q0 = *(const bf16x8*)qb; B.q1 = *(const bf16x8*)(qb + 32); }
    bf16x8 kA[4], vA[4], kB[4], vB[4];
    attn_load(c, 0, kA, vA);
    if (c.nbr) { const float* ra = rpb + ((size_t)l * 8 + h) * 15 * 31 + (rsA - rA + 7) * 31; const float* rb = rpb + ((size_t)l * 8 + h) * 15 * 31 + (rsB - rA - 1 + 7) * 31;
        float t0 = ra[lane], t1 = ra[64 + lane], t2 = ra[128 + lane], t3 = ra[min(192 + lane, 247)], t4 = rb[lane], t5 = rb[64 + lane], t6 = rb[128 + lane], t7 = rb[min(192 + lane, 247)];
        btab[lane] = t0; btab[64 + lane] = t1; btab[128 + lane] = t2; if (lane < 56) btab[192 + lane] = t3;
        btab[256 + lane] = t4; btab[320 + lane] = t5; btab[384 + lane] = t6; if (lane < 56) btab[448 + lane] = t7; }
#pragma unroll
    for (int i = 0; i < 4; ++i) { A.o[i] = (f32x4){0.f, 0.f, 0.f, 0.f}; B.o[i] = (f32x4){0.f, 0.f, 0.f, 0.f}; }
    A.m = -INFINITY; B.m = -INFINITY; A.l = 0.f; B.l = 0.f;
#pragma unroll 1
    for (int ch = 0; ch < nch; ch += 2) {
        attn_load(c, ch + 1, kB, vB);
        attn_step2(P, ch, A, B, kA, vA);
        attn_load(c, min(ch + 2, nch - 1), kA, vA);
        attn_step2(P, ch + 1, A, B, kB, vB);
    }
    attn_finish(A, O + (size_t)(qrowA + fr) * DM + h * 64 + fq * 4);
    attn_finish(B, O + (size_t)(qrowB + fr) * DM + h * 64 + fq * 4);
}

__device__ __forceinline__ void gmlp_wave_unit(int u, int phalf, int l, unsigned char* ws, const float* gn_, const float* gb_, LAS unsigned char* wl, int lane) {
    const bf16_t* Gb = (const bf16_t*)(ws + WS_G); bf16_t* O = (bf16_t*)(ws + WS_O);
    const int fr = lane & 15, fq = lane >> 4;
    const int ck = u >> 2, g = u & 3, row0 = ck * 128, p0 = 4 * phalf;
    const float* gn = gn_ + l * 256; const float* gbias = gb_ + l * 512;
    const bf16_t* gw = (const bf16_t*)(ws + WS_GW) + ((size_t)(l * 4 + g) * 128) * 128;
    LAS bf16_t* vnT = (LAS bf16_t*)wl;
    constexpr int VP = 136;
    u32x4 raw[2][8]; bf16x8 wf[4][4]; u32x2 uu[4][4]; float gbv[4]; f32x4 gnv[4];
#pragma unroll
    for (int half = 0; half < 2; ++half) { const bf16_t* src = Gb + (size_t)(row0 + half * 64 + lane) * 512 + 256 + g * 64;
#pragma unroll
        for (int i = 0; i < 8; ++i) raw[half][i] = *(const u32x4*)(src + 8 * i); }
#define GM_LO(w_) __uint_as_float((w_) << 16)
#define GM_HI(w_) __uint_as_float((w_) & 0xffff0000u)
#pragma unroll
    for (int half = 0; half < 2; ++half) {
        const int t = half * 64 + lane;
        float mu = 0.f;
#pragma unroll
        for (int i = 0; i < 8; ++i)
#pragma unroll
            for (int j = 0; j < 4; ++j) mu += GM_LO(raw[half][i][j]) + GM_HI(raw[half][i][j]);
        mu *= (1.f / 64.f);
        float var = 0.f;
#pragma unroll
        for (int i = 0; i < 8; ++i)
#pragma unroll
            for (int j = 0; j < 4; ++j) { const float a_ = GM_LO(raw[half][i][j]) - mu, b_ = GM_HI(raw[half][i][j]) - mu; var += a_ * a_ + b_ * b_; }
        const float rsd = rsqrtf(var * (1.f / 64.f) + EPS);
#pragma unroll
        for (int i = 0; i < 8; ++i)
#pragma unroll
            for (int j = 0; j < 4; ++j) { const float a_ = (GM_LO(raw[half][i][j]) - mu) * rsd, b_ = (GM_HI(raw[half][i][j]) - mu) * rsd;
                const unsigned pk = cvt_pk_bf16(a_, b_); vnT[(8 * i + 2 * j) * VP + t] = (bf16_t)(pk & 0xffffu); vnT[(8 * i + 2 * j + 1) * VP + t] = (bf16_t)(pk >> 16); }
    }
#undef GM_LO
#undef GM_HI
    LDS_WAIT(); asm volatile("" ::: "memory");
#pragma unroll
    for (int pt = 0; pt < 4; ++pt) { const bf16_t* wp = gw + (size_t)((p0 + pt) * 16 + fr) * 128 + fq * 8;
#pragma unroll
        for (int ks = 0; ks < 4; ++ks) wf[pt][ks] = *(const bf16x8*)(wp + ks * 32);
#pragma unroll
        for (int ct = 0; ct < 4; ++ct) uu[pt][ct] = *(const u32x2*)(Gb + (size_t)(row0 + (p0 + pt) * 16 + fr) * 512 + g * 64 + ct * 16 + fq * 4);
        gbv[pt] = gbias[g * 128 + (p0 + pt) * 16 + fr]; }
#pragma unroll
    for (int ct = 0; ct < 4; ++ct) gnv[ct] = *(const f32x4*)(gn + g * 64 + ct * 16 + fq * 4);
#pragma unroll
    for (int pt = 0; pt < 4; ++pt) {
        const int row_ = row0 + (p0 + pt) * 16 + fr; const float GB = gbv[pt];
#pragma unroll
        for (int ct = 0; ct < 4; ++ct) { f32x4 acc = {0.f, 0.f, 0.f, 0.f};
#pragma unroll
            for (int ks = 0; ks < 4; ++ks) { const bf16x8 a_ = *(const LAS bf16x8*)(vnT + (ct * 16 + fr) * VP + ks * 32 + fq * 8); acc = MFMA16(a_, wf[pt][ks], acc); }
            const u32x2 uw = uu[pt][ct]; const f32x4 gq = gnv[ct];
            const float u0 = __uint_as_float(uw.x << 16), u1 = __uint_as_float(uw.x & 0xffff0000u), u2 = __uint_as_float(uw.y << 16), u3 = __uint_as_float(uw.y & 0xffff0000u);
            u32x2 w_; w_.x = cvt_pk_bf16(u0 * (acc[0] * gq[0] + GB), u1 * (acc[1] * gq[1] + GB)); w_.y = cvt_pk_bf16(u2 * (acc[2] * gq[2] + GB), u3 * (acc[3] * gq[3] + GB));
            *(u32x2*)(O + (size_t)row_ * DM + 768 + g * 64 + ct * 16 + fq * 4) = w_; }
    }
    LDS_WAIT(); asm volatile("" ::: "memory");
}

#define XB_TMO      128
#define XB_XCNT(j)  (256  + 64 * (j))
#define XB_XSUB(j)  (1280 + 64 * (j))
#define XB_XGEN(j)  (2304 + 64 * (j))
#define XB_TOP      3328
#define XB_TOPGEN   3392
#define XCD_BAR_WORDS 3456
#define XB_SPIN_CAP (1u << 18)
__device__ __forceinline__ unsigned xb_ld(unsigned* p)              { return __hip_atomic_load(p, __ATOMIC_RELAXED, __HIP_MEMORY_SCOPE_AGENT); }
__device__ __forceinline__ unsigned xb_add(unsigned* p, unsigned v) { return __hip_atomic_fetch_add(p, v, __ATOMIC_RELAXED, __HIP_MEMORY_SCOPE_AGENT); }
__device__ __forceinline__ unsigned xb_xcc_id() { return (unsigned)__builtin_amdgcn_s_getreg((3 << 11) | 20) & 0xFu; }
#define XB_SPIN(cond, bar) do { unsigned _sp = 0; while (cond) { __builtin_amdgcn_s_sleep(1); \
    if ((++_sp & 255u) == 0u) { if (xb_ld(&(bar)[XB_TMO])) break; if (_sp > XB_SPIN_CAP) { atomicAdd(&(bar)[XB_TMO], 1u); break; } } } } while (0)
__device__ __forceinline__ void xcd_barrier_complete(unsigned* bar, unsigned x, unsigned& nloc, unsigned& nx) {
    const unsigned G = gridDim.x * gridDim.y * gridDim.z;
    unsigned sum, cnt, mine, sp = 0u;
    for (;;) {
        sum = 0u; cnt = 0u; mine = 0u;
#pragma unroll
        for (unsigned j = 0; j < 16; ++j) { const unsigned c = xb_ld(&bar[XB_XCNT(j)]); sum += c; cnt += (c > 0u) ? 1u : 0u; mine = (j == x) ? c : mine; }
        if (sum == G) break;
        __builtin_amdgcn_s_sleep(1);
        if ((++sp & 255u) == 0u) { if (xb_ld(&bar[XB_TMO])) break; if (sp > XB_SPIN_CAP) { atomicAdd(&bar[XB_TMO], 1u); break; } }
    }
    nloc = mine > 0u ? mine : 1u; nx = cnt > 0u ? cnt : 1u;
}
__device__ __forceinline__ void xcd_barrier(unsigned* bar, volatile LAS unsigned* st) {
    asm volatile("s_waitcnt vmcnt(0)" ::: "memory");
    __syncthreads();
    if (opaque_tid() == 0) {
        __builtin_amdgcn_s_waitcnt(0);
        const unsigned x = xb_xcc_id();
        unsigned nloc = st[0], nx = st[1];
        if (nloc == 0u) { xcd_barrier_complete(bar, x, nloc, nx); st[0] = nloc; st[1] = nx; }
        const unsigned old = xb_add(&bar[XB_XSUB(x)], 1u);
        const unsigned gen = old / nloc;
        if (old + 1u == (gen + 1u) * nloc) {
            __builtin_amdgcn_fence(__ATOMIC_RELEASE, "agent");
            asm volatile("s_waitcnt vmcnt(0)" ::: "memory");
            const unsigned og = xb_add(&bar[XB_TOP], 1u);
            const unsigned tg = og / nx;
            if (og + 1u == (tg + 1u) * nx) xb_add(&bar[XB_TOPGEN], 1u);
            else XB_SPIN(xb_ld(&bar[XB_TOPGEN]) == tg, bar);
            __builtin_amdgcn_fence(__ATOMIC_ACQUIRE, "agent");
            xb_add(&bar[XB_XGEN(x)], 1u);
            asm volatile("s_waitcnt vmcnt(0)" ::: "memory");
        } else {
            XB_SPIN(xb_ld(&bar[XB_XGEN(x)]) == gen, bar);
            __builtin_amdgcn_fence(__ATOMIC_ACQUIRE, "agent");
            asm volatile("s_waitcnt vmcnt(0)" ::: "memory");
        }
    }
    __syncthreads();
}
constexpr int CW_BAR = 4096;
constexpr int LDS_BARW = 147200;

#ifndef PROBE_SYNC
#define PROBE_SYNC 0
#endif
#ifndef PROBE_MIX
#define PROBE_MIX 0
#endif
#ifndef PROBE_PRO
#define PROBE_PRO 0
#endif
#ifndef PROBE_NORM
#define PROBE_NORM 0
#endif
#ifndef PROBE_G
#define PROBE_G 0
#endif
#define XSYNC() xcd_barrier((unsigned*)(pp->ws + WS_CTL) + CW_BAR, (volatile LAS unsigned*)(lds + LDS_BARW))
#define GSYNC() do { LAUNDER(pp); XSYNC(); if (PROBE_SYNC) { LAUNDER(pp); XSYNC(); } } while (0)
#if defined(__HIP_DEVICE_COMPILE__)
typedef const __attribute__((address_space(4))) Params* PP;
#else
typedef const Params* PP;
#endif
#define LAUNDER(pp) asm volatile("" : "+s"(pp) :: "memory")
#define LOADP(pp) (*(const Params*)(pp))

__device__ __forceinline__ void norm_step(PP pp, int l, int sub, bool dummy = false) {
    const Params p = *pp;
    const int G = gridDim.x;
    const float* mod = (const float*)(p.ws + WS_MOD);
    if (sub == 0) { const int lp = l > 0 ? l - 1 : 0;
        norm_phase(p, G, l == 0, l > 0, true, 0.5f, dummy, mod + (size_t)lp * 5 * 9216 + 8 * 1024, p.norm_post + (lp * 3 + 2) * DM, mod + (size_t)l * 5 * 9216, p.norm_pre + (l * 3 + 0) * DM); }
    else if (sub == 1) norm_phase(p, G, false, true, true, 0.5f, dummy, mod + (size_t)l * 5 * 9216 + 2 * 1024, p.norm_post + (l * 3 + 0) * DM, mod + (size_t)l * 5 * 9216 + 3 * 1024, p.norm_pre + (l * 3 + 1) * DM);
    else if (sub == 2) norm_phase(p, G, false, true, true, 1.0f, dummy, mod + (size_t)l * 5 * 9216 + 5 * 1024, p.norm_post + (l * 3 + 1) * DM, mod + (size_t)l * 5 * 9216 + 6 * 1024, p.norm_pre + (l * 3 + 2) * DM);
    else norm_phase(p, G, false, true, false, 0.5f, dummy, mod + (size_t)3 * 5 * 9216 + 8 * 1024, p.norm_post + (3 * 3 + 2) * DM, mod, p.norm_pre);
}

__global__ void __launch_bounds__(NTHR, 2) fwd_kernel(Params p_unused) {
    extern __shared__ __attribute__((aligned(16))) unsigned char lds_raw[];
    LAS unsigned char* lds = (LAS unsigned char*)lds_raw;
    cg::grid_group grid = cg::this_grid();
    PP pp = (PP)__builtin_amdgcn_kernarg_segment_ptr();
    LAUNDER(pp);
    if (threadIdx.x == 0) { ((volatile LAS unsigned*)(lds + LDS_BARW))[0] = 0u; ((volatile LAS unsigned*)(lds + LDS_BARW))[1] = 0u;
        (void)xb_add((unsigned*)(pp->ws + WS_CTL) + CW_BAR + XB_XCNT(xb_xcc_id()), 1u); }
    __syncthreads();
    { const Params p = *pp; prologue(p, lds, gridDim.x); }
    if (PROBE_PRO) { GSYNC(); LAUNDER(pp); const Params p = *pp; prologue(p, lds, gridDim.x); }
    GSYNC();
    if (gridDim.y == 0xFFFFu) grid.sync();

#pragma unroll 1
    for (int l = 0; l < NLAYER; ++l) {
        LAUNDER(pp);
        if (PROBE_NORM) { norm_step(pp, l, 0, true); LAUNDER(pp); }
        norm_step(pp, l, 0);
        GSYNC();
#pragma unroll 1
        for (int s = 0; s < 2; ++s) {
            LAUNDER(pp);
#pragma unroll 1
            for (int rep = 0; rep <= ((PROBE_G & 1) ? 1 : 0); ++rep) {
                LAUNDER(pp);
                unsigned char* ws = pp->ws; const unsigned char* wl = ws + WS_W + (size_t)l * W_LAYER;
                pg8::Gemm g{(const bf16_t*)(ws + WS_H), (const bf16_t*)(wl + W_FWI + s * SZ_FWI)}; pg8::StaticOrder S; S.init(MTOK / 256, NFI / 256, 1, gridDim.x, opaque_bx());
                EpiSwiglu E{ws};
                pg8::gemm_phase<DM, DM, DM, EpiSwiglu, pg8::StaticOrder>(lds, g, S, E);
                if (rep == 0 && opaque_bx() >= 192 && (s == 0 || l + 1 < NLAYER)) {
                    LAUNDER(pp); const Params p = *pp;
                    fwi0_items(p, lds, s == 0 ? l : l + 1, s == 0 ? 1 : 0, (opaque_bx() - 192) * NWAVES, 64 * NWAVES);
                }
            }
            GSYNC();
            LAUNDER(pp);
#pragma unroll 1
            for (int rep = 0; rep <= ((PROBE_G & 2) ? 1 : 0); ++rep) {
                LAUNDER(pp);
                unsigned char* ws = pp->ws; const unsigned char* wl = ws + WS_W + (size_t)l * W_LAYER;
                pg8::Gemm g{(const bf16_t*)(ws + WS_A2), (const bf16_t*)(wl + W_FWO + s * SZ_FWO)}; pg8::StaticOrder S; S.init(MTOK / 256, DM / 256, 2, gridDim.x, opaque_bx());
                EpiF32 E{ws};
                pg8::gemm_phase<FF, FF, FF / 2, EpiF32, pg8::StaticOrder>(lds, g, S, E);
            }
            GSYNC();
            if (s == 1) break;
            LAUNDER(pp);
            if (PROBE_NORM) { norm_step(pp, l, 1, true); LAUNDER(pp); }
            norm_step(pp, l, 1);
            GSYNC();
            LAUNDER(pp);
            {
                LAUNDER(pp);
                unsigned char* ws = pp->ws; const unsigned char* wl = ws + WS_W + (size_t)l * W_LAYER;
                pg8::Gemm g{(const bf16_t*)(ws + WS_H), (const bf16_t*)(wl + W_WIN)}; pg8::StaticOrder S; S.init(MTOK / 256, 8, 1, gridDim.x, opaque_bx());
                EpiMixIn E{ws, pp->out, l};
                pg8::gemm_phase<DM, DM, DM, EpiMixIn, pg8::StaticOrder>(lds, g, S, E);
            }
            GSYNC();
            LAUNDER(pp);
            {
                unsigned char* ws = pp->ws; const unsigned char* wl = ws + WS_W + (size_t)l * W_LAYER;
                const int bx = opaque_bx();
                const int tid_ = opaque_tid(); const int lane = tid_ & 63, wave = __builtin_amdgcn_readfirstlane(tid_ >> 6);
                LAS unsigned* wcnt = (LAS unsigned*)(lds + LDS_BARW + 16);
                if (bx < 64) {
                    {   pg8::Gemm g{(const bf16_t*)(ws + WS_H), (const bf16_t*)(wl + W_WIN)}; pg8::SubsetOrder S{0, 32, 64, bx, 8};
                        EpiMixIn E{ws, pp->out, l};
                        pg8::gemm_phase<DM, DM, DM, EpiMixIn, pg8::SubsetOrder>(lds, g, S, E); }
                    LAUNDER(pp);
                    unsigned* tcnt = (unsigned*)(pp->ws + WS_CTL) + 2048 + 64 * l;
                    asm volatile("s_waitcnt vmcnt(0)" ::: "memory"); __syncthreads();
                    if (tid_ == 0) { __builtin_amdgcn_fence(__ATOMIC_RELEASE, "agent"); asm volatile("s_waitcnt vmcnt(0)" ::: "memory"); (void)xb_add(tcnt, 1u);
                        unsigned sp = 0u; while (xb_ld(tcnt) < 64u) { __builtin_amdgcn_s_sleep(2); if (++sp > (1u << 22)) break; }
                        __builtin_amdgcn_fence(__ATOMIC_ACQUIRE, "agent"); asm volatile("s_waitcnt vmcnt(0)" ::: "memory"); *wcnt = 0u; }
                    __syncthreads();
                    for (;;) {
                        unsigned n = 0; if (lane == 0) n = __hip_atomic_fetch_add(wcnt, 1u, __ATOMIC_RELAXED, __HIP_MEMORY_SCOPE_WORKGROUP); n = __builtin_amdgcn_readfirstlane(n);
                        if (n >= 8u) break;
                        LAUNDER(pp);
                        gmlp_wave_unit(bx * 4 + (int)(n >> 1), (int)(n & 1u), l, pp->ws, pp->gmlp_norm, pp->gmlp_b, lds + wave * 17408, lane);
                    }
                } else if (bx < 96) {
                    {   pg8::Gemm g{(const bf16_t*)(ws + WS_DFTS), (const bf16_t*)(ws + WS_TT) + 2097152}; pg8::SubsetOrder S{64, 4, 16, bx, 0};
                        EpiFourier E{ws, MPR, 1024};
                        pg8::gemm_phase<2048, 2048, 2048, EpiFourier, pg8::SubsetOrder>(lds, g, S, E); }
                    LAUNDER(pp); ws = pp->ws;
                    {   pg8::Gemm g{(const bf16_t*)(ws + WS_DFTP), (const bf16_t*)(ws + WS_TT)}; pg8::SubsetOrder S{80, 1, 16, bx, 0};
                        EpiFourier E{ws, 0, 256};
                        pg8::gemm_phase<512, 512, 512, EpiFourier, pg8::SubsetOrder>(lds, g, S, E); }
                }
                __syncthreads();
                if (tid_ == 0) *wcnt = 0u;
                __syncthreads();
                const int sh = bx < 96 ? 0 : 1, cs0 = bx < 96 ? 0 : bx - 96;
                const int i0 = cs0 * 2048 / 160, i1 = (cs0 + sh) * 2048 / 160;
                for (;;) {
                    if (gridDim.x != 256) break;
                    unsigned n = 0; if (lane == 0) n = __hip_atomic_fetch_add(wcnt, 1u, __ATOMIC_RELAXED, __HIP_MEMORY_SCOPE_WORKGROUP); n = __builtin_amdgcn_readfirstlane(n);
                    const int e0 = (i0 + 1) & ~1, ne = i1 > e0 ? (i1 - e0 + 1) >> 1 : 0, o0 = i0 | 1;
                    const int i = (int)n < ne ? e0 + 2 * (int)n : o0 + 2 * ((int)n - ne);
                    if (i >= i1) break;
                    LAUNDER(pp);
                    attn_wave_unit((i & 1) * 1024 + (i >> 1), l, pp->ws, pp->rpb, lds + wave * 17408, lane);
                }
            }
            GSYNC();
            LAUNDER(pp);
#pragma unroll 1
            for (int rep = 0; rep <= ((PROBE_G & 8) ? 1 : 0); ++rep) {
                LAUNDER(pp);
                unsigned char* ws = pp->ws; const unsigned char* wl = ws + WS_W + (size_t)l * W_LAYER;
                pg8::Gemm g{(const bf16_t*)(ws + WS_O), (const bf16_t*)(wl + W_WOUT)}; pg8::StaticOrder S; S.init(MTOK / 256, DM / 256, 2, gridDim.x, opaque_bx());
                EpiF32 E{ws};
                pg8::gemm_phase<DM, DM, DM / 2, EpiF32, pg8::StaticOrder>(lds, g, S, E);
            }
            GSYNC();
            LAUNDER(pp);
            if (PROBE_NORM) { norm_step(pp, l, 2, true); LAUNDER(pp); }
            norm_step(pp, l, 2);
            GSYNC();
        }
    }
    LAUNDER(pp);
    if (PROBE_NORM) { norm_step(pp, 0, 3, true); LAUNDER(pp); }
    norm_step(pp, 0, 3);
}

extern "C" void kernel_launch(void* const* d_in, const int* in_sizes, int n_in, void* d_out, int out_size, void* d_ws, size_t ws_size, hipStream_t stream) {
    static int grid = 0;
    if (grid == 0) {
        if (n_in != 18 || ws_size < WS_END) { fprintf(stderr, "kernel_launch: need 18 inputs and >= %zu bytes of workspace (got %d, %zu)\n", (size_t)WS_END, n_in, ws_size); grid = -1; return; }
        int dev = 0, cus = 0, per_cu = 0;
        hipGetDevice(&dev); hipDeviceGetAttribute(&cus, hipDeviceAttributeMultiprocessorCount, dev);
        if (hipFuncSetAttribute((const void*)fwd_kernel, hipFuncAttributeMaxDynamicSharedMemorySize, LDS_BYTES) != hipSuccess) { fprintf(stderr, "kernel_launch: hipFuncSetAttribute failed\n"); grid = -1; return; }
        if (hipOccupancyMaxActiveBlocksPerMultiprocessor(&per_cu, (const void*)fwd_kernel, NTHR, LDS_BYTES) != hipSuccess || per_cu < 1) { fprintf(stderr, "kernel_launch: occupancy query failed (%d)\n", per_cu); per_cu = 1; }
        (void)hipGetLastError();
        grid = cus * 1;
        fprintf(stderr, "kernel_launch: grid %d (per_cu %d)\n", grid, per_cu);
    }
    if (grid < 0) return;
    (void)hipMemsetAsync((char*)d_ws + WS_CTL, 0, CTL_BYTES, stream);
    Params p{};
    p.x_prompt = (const float*)d_in[0]; p.x_sample = (const float*)d_in[1]; p.cache_k = (const float*)d_in[2]; p.cache_v = (const float*)d_in[3];
    p.c = (const float*)d_in[4]; p.c_ctx = (const float*)d_in[5]; p.ada_w = (const float*)d_in[6]; p.ada_b = (const float*)d_in[7];
    p.norm_pre = (const float*)d_in[8]; p.norm_post = (const float*)d_in[9]; p.ffn_w_in = (const float*)d_in[10]; p.ffn_w_out = (const float*)d_in[11];
    p.w_in = (const float*)d_in[12]; p.w_out = (const float*)d_in[13]; p.rpb = (const float*)d_in[14]; p.gmlp_norm = (const float*)d_in[15];
    p.gmlp_w = (const float*)d_in[16]; p.gmlp_b = (const float*)d_in[17];
    p.out = (float*)d_out; p.ws = (unsigned char*)d_ws;
    void* args[] = {&p};
    hipError_t e = hipLaunchCooperativeKernel((const void*)fwd_kernel, dim3(grid), dim3(NTHR), args, LDS_BYTES, stream);
    if (e != hipSuccess) fprintf(stderr, "kernel_launch: cooperative launch failed: %s (grid %d)\n", hipGetErrorString(e), grid);
}
```

```cpp
#include <hip/hip_runtime.h>
#include <hip/hip_cooperative_groups.h>
#include <cstdio>
#include <cstdint>
namespace cg = cooperative_groups;

#define LAS __attribute__((address_space(3)))
typedef unsigned short bf16_t;
typedef short bf16x8 __attribute__((ext_vector_type(8)));
typedef float f32x4 __attribute__((ext_vector_type(4)));
typedef unsigned u32x4 __attribute__((ext_vector_type(4)));
typedef unsigned u32x2 __attribute__((ext_vector_type(2)));

constexpr int DM = 1024, MTOK = 8192, MPR = 4096, FF = 2816, NFI = 2 * FF, NMI = 2560, NLAYER = 4;
constexpr int NWAVES = 8, NTHR = 512;
constexpr int LDS_BYTES = 147456;
constexpr float EPS = 1e-6f;

constexpr size_t MiB = 1u << 20;
constexpr size_t WS_CTL = 0, CTL_BYTES = 65536;
constexpr size_t WS_MOD = 1 * MiB;
constexpr size_t WS_DFTS = 2 * MiB;
constexpr size_t WS_DFTP = 6 * MiB;
constexpr size_t WS_CK = 7 * MiB;
constexpr size_t WS_CVT = 11 * MiB;
constexpr size_t WS_GW = 15 * MiB;
constexpr size_t WS_H = 16 * MiB;
constexpr size_t WS_Q = 32 * MiB;
constexpr size_t WS_K = 40 * MiB;
constexpr size_t WS_VT = 48 * MiB;
constexpr size_t WS_TT = 56 * MiB;
constexpr size_t WS_G = 64 * MiB;
constexpr size_t WS_O = 72 * MiB;
constexpr size_t WS_A2 = 88 * MiB;
constexpr size_t WS_Y = 136 * MiB;
constexpr size_t WS_W = 200 * MiB;
constexpr size_t W_FWI = 0, SZ_FWI = (size_t)NFI * DM * 2;
constexpr size_t W_FWO = 2 * SZ_FWI, SZ_FWO = (size_t)DM * FF * 2;
constexpr size_t W_WIN = W_FWO + 2 * SZ_FWO, SZ_WIN = (size_t)NMI * DM * 2;
constexpr size_t W_WOUT = W_WIN + SZ_WIN, SZ_WOUT = (size_t)DM * DM * 2;
constexpr size_t W_LAYER = W_WOUT + SZ_WOUT;
constexpr size_t WS_END = WS_W + NLAYER * W_LAYER;

struct Params {
    const float *x_prompt, *x_sample, *cache_k, *cache_v, *c, *c_ctx, *ada_w, *ada_b, *norm_pre, *norm_post, *ffn_w_in, *ffn_w_out, *w_in, *w_out, *rpb, *gmlp_norm, *gmlp_w, *gmlp_b;
    float* out; unsigned char* ws;
};

__device__ __forceinline__ unsigned cvt_pk_bf16(float lo, float hi) { unsigned r; asm volatile("v_cvt_pk_bf16_f32 %0, %1, %2" : "=v"(r) : "v"(lo), "v"(hi)); return r; }
__device__ __forceinline__ float wave_sum(float v) {
#pragma unroll
    for (int o = 1; o < 64; o <<= 1) v += __shfl_xor(v, o);
    return v;
}
#define LDS_WAIT() asm volatile("s_waitcnt lgkmcnt(0)" ::: "memory")
__device__ __forceinline__ int opaque_bx() { int b = blockIdx.x; asm volatile("" : "+s"(b)); return b; }
__device__ __forceinline__ int opaque_tid() { int t = threadIdx.x; asm volatile("" : "+v"(t)); return t; }

namespace pg8 {
constexpr int BM = 256, BK = 64, HALF = 128, HTB = HALF * BK * 2, STAGE_BYTES = 8 * HTB, NXCD = 8, WGM = 8;
__host__ __device__ __forceinline__ int lds_byte(int r, int c) { const int st = (r >> 4) * 2 + (c >> 5), rr = r & 15, cc = c & 31, ob = rr * 64 + cc * 2; return st * 1024 + (ob ^ (((ob >> 9) & 1) << 5)); }
__host__ __device__ __forceinline__ void stage_rc(int b, int& R, int& C) { const int st = b / 1024, sb = b % 1024, swz = sb ^ (((sb >> 9) & 1) << 5); R = (st >> 1) * 16 + swz / 64; C = (st & 1) * 32 + (swz % 64) / 2; }
__host__ __device__ __forceinline__ int perm32(int rho) { const int n = rho >> 4, i = rho & 15; return 8 * (i >> 2) + 4 * n + (i & 3); }

struct Unit { int pm, pn, ks; };
struct Gemm { const bf16_t* A; const bf16_t* Bt; };

struct StaticOrder {
    int nM, nN, nwg, G, c, nMr, gap_at, gap;
    __device__ void init(int nM_, int nN_, int ksplit, int G_, int c_, int gap_at_ = 1 << 20, int gap_ = 0) { nMr = nM_; nM = nM_ * ksplit; nN = nN_; nwg = nM * nN; G = G_; c = c_; gap_at = gap_at_; gap = gap_; }
    __device__ bool next(int i, Unit& u) const {
        const long L = (long)i * G + c; if (L >= nwg) return false;
        int wgid = (int)L; { const int q = nwg / NXCD, r = nwg % NXCD, xcd = wgid % NXCD, off = wgid / NXCD; wgid = (xcd < r ? xcd * (q + 1) : r * (q + 1) + (xcd - r) * q) + off; }
        const int nig = WGM * nN, gid = wgid / nig, fm = gid * WGM, gsz = (nM - fm) < WGM ? (nM - fm) : WGM;
        const int pmv = fm + ((wgid % nig) % gsz); u.pn = (wgid % nig) / gsz; if (u.pn >= gap_at) u.pn += gap; u.ks = pmv / nMr; u.pm = pmv % nMr; return true;
    }
};
struct SubsetOrder {
    int c0, nM, n, c, pn0;
    __device__ bool next(int i, Unit& u) const { const int j = c - c0; if (i != 0 || j < 0 || j >= n) return false; u.pm = j % nM; u.pn = pn0 + j / nM; u.ks = 0; return true; }
};

template <int LDA, int LDB, int KLOOP, class Epi, class Sched, bool ALIGN_EPI = true, bool SP2 = true>
__device__ __forceinline__ void gemm_phase(LAS unsigned char* lds, const Gemm g, const Sched& S, const Epi& E) {
    const int tid = opaque_tid(), wid = __builtin_amdgcn_readfirstlane(tid >> 6), lane = tid & 63, wr = wid >> 2, wc = wid & 3, fr = lane & 15, fq = lane >> 4;
    constexpr int nt = KLOOP / BK;
    unsigned voffA[2], voffB[2];
#pragma unroll
    for (int i = 0; i < 2; ++i) { int R, C; stage_rc(tid * 16 + i * 8192, R, C); const int Rb = Epi::PERM ? ((R & ~31) + perm32(R & 31)) : R;
        voffA[i] = (unsigned)(R * LDA + C) * 2u; voffB[i] = (unsigned)(Rb * LDB + C) * 2u; }
    constexpr size_t kstep = (size_t)(BK * 2);
    constexpr size_t hstepA = (size_t)HALF * LDA * 2, hstepB = (size_t)HALF * LDB * 2;
    constexpr size_t tstepA = 2 * hstepA, tstepB = 2 * hstepB;
    const unsigned ldsw = (unsigned)wid * 1024u;
    const int aoff = lds_byte(wr * 64 + fr, fq * 8), boff = lds_byte(wc * 32 + fr, fq * 8);
#define PG8_SA(b, h) (((b) * 2 + (h)) * HTB)
#define PG8_SB(b, h) ((4 + (b) * 2 + (h)) * HTB)
#define PG8_STAGE(bufoff, gbase, voff) do { _Pragma("unroll") for (int _i = 0; _i < 2; ++_i) \
        __builtin_amdgcn_global_load_lds((const unsigned*)((const char*)(gbase) + (voff)[_i]), (LAS unsigned*)(lds + (bufoff) + ldsw + _i * 8192), 16, 0, 0); } while (0)
#define PG8_LDA(dst, b, h) do { _Pragma("unroll") for (int m = 0; m < 4; ++m) _Pragma("unroll") for (int k = 0; k < 2; ++k) dst[m][k] = *(const LAS bf16x8*)(lds + PG8_SA(b, h) + aoff + m * 2048 + k * 1024); } while (0)
#define PG8_LDB(dst, b, h) do { _Pragma("unroll") for (int n = 0; n < 2; ++n) _Pragma("unroll") for (int k = 0; k < 2; ++k) dst[n][k] = *(const LAS bf16x8*)(lds + PG8_SB(b, h) + boff + n * 2048 + k * 1024); } while (0)
#define PG8_MMA(ai, bj, At, Bt) do { __builtin_amdgcn_s_setprio(1); _Pragma("unroll") for (int m = 0; m < 4; ++m) _Pragma("unroll") for (int n = 0; n < 2; ++n) _Pragma("unroll") for (int k = 0; k < 2; ++k) \
        acc[ai][bj][m][n] = __builtin_amdgcn_mfma_f32_16x16x32_bf16(Bt[n][k], At[m][k], acc[ai][bj][m][n], 0, 0, 0); __builtin_amdgcn_s_setprio(0); } while (0)
#define PG8_WAIT_V(n) asm volatile("s_waitcnt vmcnt(" #n ")" ::: "memory")
#define PG8_WAIT_L(n) asm volatile("s_waitcnt lgkmcnt(" #n ")" ::: "memory")
#define PG8_BAR __builtin_amdgcn_s_barrier()
#define PG8_SCHED __builtin_amdgcn_sched_barrier(0)
    Unit cur, nxt; int ui = 0;
    if (!S.next(0, cur)) return;
    f32x4 acc[2][2][4][2];
#pragma unroll
    for (int a = 0; a < 2; ++a)
#pragma unroll
        for (int b = 0; b < 2; ++b)
#pragma unroll
            for (int m = 0; m < 4; ++m)
#pragma unroll
                for (int n = 0; n < 2; ++n) acc[a][b][m][n] = (f32x4){0.f, 0.f, 0.f, 0.f};
    bf16x8 At[4][2], B0[2][2], B1[2][2];
    constexpr size_t ksoff = (size_t)KLOOP * 2;
    const char* cA = (const char*)g.A + (size_t)cur.pm * tstepA + (size_t)cur.ks * ksoff; const char* cB = (const char*)g.Bt + (size_t)cur.pn * tstepB + (size_t)cur.ks * ksoff;
    if constexpr (SP2) {
        PG8_STAGE(PG8_SB(0, 0), cB, voffB); PG8_STAGE(PG8_SB(0, 1), cB + hstepB, voffB); PG8_STAGE(PG8_SA(0, 0), cA, voffA); PG8_STAGE(PG8_SA(0, 1), cA + hstepA, voffA);
        if (wr == 1) PG8_BAR;
        PG8_WAIT_V(2); PG8_BAR;
        PG8_STAGE(PG8_SB(1, 0), cB + kstep, voffB); PG8_STAGE(PG8_SA(1, 0), cA + kstep, voffA); PG8_STAGE(PG8_SB(1, 1), cB + hstepB + kstep, voffB);
        PG8_WAIT_V(6); PG8_BAR;
    }
    for (;;) {
        const bool has_next = S.next(ui + 1, nxt);
        const char* nA = has_next ? (const char*)g.A + (size_t)nxt.pm * tstepA + (size_t)nxt.ks * ksoff : cA; const char* nB = has_next ? (const char*)g.Bt + (size_t)nxt.pn * tstepB + (size_t)nxt.ks * ksoff : cB;
        for (int t = 0; t < nt; t += 2) {
            const bool last = (t == nt - 2);
            const char* a1 = cA + (size_t)(t + 1) * kstep;
            const char* a2 = last ? nA : cA + (size_t)(t + 2) * kstep; const char* b2 = last ? nB : cB + (size_t)(t + 2) * kstep;
            const char* a3 = a2 + kstep; const char* b3 = b2 + kstep;
            PG8_LDB(B0, 0, 0); PG8_LDB(B1, 0, 1); PG8_SCHED; PG8_LDA(At, 0, 0); PG8_STAGE(PG8_SA(1, 1), a1 + hstepA, voffA);
            PG8_WAIT_V(8); PG8_WAIT_L(0); PG8_BAR; PG8_MMA(0, 0, At, B0); PG8_MMA(0, 1, At, B1); PG8_BAR; PG8_SCHED;
            PG8_LDA(At, 0, 1); PG8_STAGE(PG8_SB(0, 0), b2, voffB); PG8_STAGE(PG8_SB(0, 1), b2 + hstepB, voffB); PG8_STAGE(PG8_SA(0, 0), a2, voffA);
            PG8_WAIT_V(8); PG8_WAIT_L(0); PG8_BAR; PG8_MMA(1, 0, At, B0); PG8_MMA(1, 1, At, B1); PG8_BAR; PG8_SCHED;
            PG8_LDB(B0, 1, 0); PG8_LDB(B1, 1, 1); PG8_SCHED; PG8_LDA(At, 1, 0); PG8_STAGE(PG8_SA(0, 1), a2 + hstepA, voffA);
            PG8_WAIT_V(8); PG8_WAIT_L(0); PG8_BAR; PG8_MMA(0, 0, At, B0); PG8_MMA(0, 1, At, B1); PG8_BAR; PG8_SCHED;
            PG8_LDA(At, 1, 1); PG8_STAGE(PG8_SB(1, 0), b3, voffB); PG8_STAGE(PG8_SB(1, 1), b3 + hstepB, voffB); PG8_STAGE(PG8_SA(1, 0), a3, voffA);
            PG8_WAIT_V(8); PG8_WAIT_L(0); PG8_BAR; PG8_MMA(1, 0, At, B0); PG8_MMA(1, 1, At, B1); PG8_BAR; PG8_SCHED;
        }
        if constexpr (ALIGN_EPI) { if (wr == 0) PG8_BAR; }
        E(acc, cur, wr, wc, fr, fq);
        if (!has_next) break;
#pragma unroll
        for (int a = 0; a < 2; ++a)
#pragma unroll
            for (int b = 0; b < 2; ++b)
#pragma unroll
                for (int m = 0; m < 4; ++m)
#pragma unroll
                    for (int n = 0; n < 2; ++n) acc[a][b][m][n] = (f32x4){0.f, 0.f, 0.f, 0.f};
        cur = nxt; cA = nA; cB = nB; ++ui;
        if constexpr (ALIGN_EPI) { if (wr == 1) PG8_BAR; }
    }
    PG8_WAIT_V(0);
    if constexpr (!ALIGN_EPI) { if (wr == 0) PG8_BAR; }
    PG8_BAR;
#undef PG8_SA
#undef PG8_SB
#undef PG8_STAGE
#undef PG8_LDA
#undef PG8_LDB
#undef PG8_MMA
#undef PG8_WAIT_V
#undef PG8_WAIT_L
#undef PG8_BAR
#undef PG8_SCHED
}
}

__device__ __forceinline__ float silu_f(float v) { return v * __builtin_amdgcn_rcpf(1.f + __expf(-v)); }
__device__ __forceinline__ float gelu_tanh_f(float v) { const float u = 0.7978845608f * (v + 0.044715f * v * v * v); const float t = __expf(2.f * u); const float th = 1.f - 2.f * __builtin_amdgcn_rcpf(t + 1.f); return 0.5f * v * (1.f + th); }

struct EpiSwiglu {
    static constexpr bool PERM = true;
    unsigned char* ws;
    __device__ __forceinline__ void operator()(const f32x4 (&acc)[2][2][4][2], const pg8::Unit& u, int wr, int wc, int fr, int fq) const {
        bf16_t* A2 = (bf16_t*)(ws + WS_A2);
        const int row0 = u.pm * 256 + wr * 64 + fr, col0 = u.pn * 128 + wc * 32 + 8 * fq;
#pragma unroll
        for (int ai = 0; ai < 2; ++ai)
#pragma unroll
            for (int m = 0; m < 4; ++m) {
                const f32x4 g0 = acc[ai][0][m][0], g1 = acc[ai][0][m][1], u0 = acc[ai][1][m][0], u1 = acc[ai][1][m][1];
                u32x4 w;
                w.x = cvt_pk_bf16(silu_f(g0[0]) * u0[0], silu_f(g0[1]) * u0[1]); w.y = cvt_pk_bf16(silu_f(g0[2]) * u0[2], silu_f(g0[3]) * u0[3]);
                w.z = cvt_pk_bf16(silu_f(g1[0]) * u1[0], silu_f(g1[1]) * u1[1]); w.w = cvt_pk_bf16(silu_f(g1[2]) * u1[2], silu_f(g1[3]) * u1[3]);
                *(u32x4*)(A2 + (size_t)(row0 + ai * 128 + m * 16) * FF + col0) = w;
            }
    }
};
struct EpiF32 {
    static constexpr bool PERM = true;
    unsigned char* ws;
    __device__ __forceinline__ void operator()(const f32x4 (&acc)[2][2][4][2], const pg8::Unit& u, int wr, int wc, int fr, int fq) const {
        bf16_t* base = (bf16_t*)(ws + WS_Y) + (size_t)u.ks * MTOK * DM + (size_t)(u.pm * 256 + wr * 64 + fr) * DM + u.pn * 256 + wc * 32 + 8 * fq;
#pragma unroll
        for (int ai = 0; ai < 2; ++ai)
#pragma unroll
            for (int m = 0; m < 4; ++m)
#pragma unroll
                for (int bj = 0; bj < 2; ++bj) { const f32x4 v0 = acc[ai][bj][m][0], v1 = acc[ai][bj][m][1];
                    u32x4 w; w.x = cvt_pk_bf16(v0[0], v0[1]); w.y = cvt_pk_bf16(v0[2], v0[3]); w.z = cvt_pk_bf16(v1[0], v1[1]); w.w = cvt_pk_bf16(v1[2], v1[3]);
                    *(u32x4*)(base + (size_t)(ai * 128 + m * 16) * DM + bj * 128) = w; }
    }
};
struct EpiMixIn {
    static constexpr bool PERM = true;
    unsigned char* ws; float* out; int l;
    __device__ __forceinline__ void operator()(const f32x4 (&acc)[2][2][4][2], const pg8::Unit& u, int wr, int wc, int fr, int fq) const {
        bf16_t* Qb = (bf16_t*)(ws + WS_Q); bf16_t* Kb = (bf16_t*)(ws + WS_K); bf16_t* VT = (bf16_t*)(ws + WS_VT); bf16_t* TT = (bf16_t*)(ws + WS_TT); bf16_t* Gb = (bf16_t*)(ws + WS_G);
        float* newk = out + (size_t)MTOK * DM; float* newv = newk + (size_t)16 * 4 * 256 * 512;
        const int pn = u.pn;
        const bool prompt = u.pm < 16;
#pragma unroll
        for (int ai = 0; ai < 2; ++ai)
#pragma unroll
            for (int m = 0; m < 4; ++m) {
                const int row = u.pm * 256 + ai * 128 + wr * 64 + m * 16 + fr;
                const int bb = prompt ? (row >> 8) : ((row - MPR) >> 10), tt = prompt ? (row & 255) : ((row - MPR) & 1023);
#pragma unroll
                for (int bj = 0; bj < 2; ++bj) {
                    const int ct = bj * 128 + wc * 32 + 8 * fq;
                    f32x4 v0 = acc[ai][bj][m][0], v1 = acc[ai][bj][m][1];
                    if (pn < 2) {
                        v0 = v0 * 0.125f; v1 = v1 * 0.125f; u32x4 w; w.x = cvt_pk_bf16(v0[0], v0[1]); w.y = cvt_pk_bf16(v0[2], v0[3]); w.z = cvt_pk_bf16(v1[0], v1[1]); w.w = cvt_pk_bf16(v1[2], v1[3]);
                        *(u32x4*)(Qb + (size_t)row * 512 + pn * 256 + ct) = w;
                    } else if (pn < 4) {
                        const int c0 = (pn - 2) * 256 + ct;
                        u32x4 w; w.x = cvt_pk_bf16(v0[0], v0[1]); w.y = cvt_pk_bf16(v0[2], v0[3]); w.z = cvt_pk_bf16(v1[0], v1[1]); w.w = cvt_pk_bf16(v1[2], v1[3]);
                        { const int hd = c0 >> 6, dd = c0 & 63;
                          bf16_t* kd = prompt ? Kb + ((size_t)((bb * 8 + hd) * 256 + tt)) * 64 + dd : Kb + 2097152 + ((size_t)((bb * 8 + hd) * 1024 + tt)) * 64 + dd;
                          *(u32x4*)kd = w; }
                        if (prompt) { float* o = newk + ((size_t)(bb * 4 + l) * 256 + tt) * 512 + c0; __builtin_nontemporal_store(v0, (f32x4*)o); __builtin_nontemporal_store(v1, (f32x4*)(o + 4)); }
                    } else if (pn < 6) {
                        const int c0 = (pn - 4) * 256 + ct;
                        if (prompt) { float* o = newv + ((size_t)(bb * 4 + l) * 256 + tt) * 512 + c0; __builtin_nontemporal_store(v0, (f32x4*)o); __builtin_nontemporal_store(v1, (f32x4*)(o + 4)); }
                        const int hd = c0 >> 6, dd = c0 & 63;
                        bf16_t* vt = prompt ? VT + ((size_t)((bb * 8 + hd) * 8 + (tt >> 5))) * 2048 + dd * 32 + (tt & 31) : VT + 2097152 + ((size_t)((bb * 8 + hd) * 16 + (tt >> 6))) * 4096 + dd * 64 + (tt & 63);
                        const size_t vp = prompt ? 32 : 64;
#pragma unroll
                        for (int i = 0; i < 4; ++i) { vt[(size_t)i * vp] = (bf16_t)(cvt_pk_bf16(v0[i], v0[i]) & 0xffffu); vt[(size_t)(i + 4) * vp] = (bf16_t)(cvt_pk_bf16(v1[i], v1[i]) & 0xffffu); }
                    } else if (pn < 8) {
                        const int half = pn - 6;
                        bf16_t* t = prompt ? TT + ((size_t)(bb * 256 + ct) * 512 + half * 256 + tt) : TT + 2097152 + ((size_t)(bb * 256 + ct) * 2048 + half * 1024 + tt);
                        const size_t tp = prompt ? 512 : 2048;
#pragma unroll
                        for (int i = 0; i < 4; ++i) { t[(size_t)i * tp] = (bf16_t)(cvt_pk_bf16(v0[i], v0[i]) & 0xffffu); t[(size_t)(i + 4) * tp] = (bf16_t)(cvt_pk_bf16(v1[i], v1[i]) & 0xffffu); }
                    } else {
                        u32x4 w; w.x = cvt_pk_bf16(gelu_tanh_f(v0[0]), gelu_tanh_f(v0[1])); w.y = cvt_pk_bf16(gelu_tanh_f(v0[2]), gelu_tanh_f(v0[3]));
                        w.z = cvt_pk_bf16(gelu_tanh_f(v1[0]), gelu_tanh_f(v1[1])); w.w = cvt_pk_bf16(gelu_tanh_f(v1[2]), gelu_tanh_f(v1[3]));
                        *(u32x4*)(Gb + (size_t)row * 512 + (pn - 8) * 256 + ct) = w;
                    }
                }
            }
    }
};
struct EpiFourier {
    static constexpr bool PERM = true;
    unsigned char* ws; int row0, rpb_;
    __device__ __forceinline__ void operator()(const f32x4 (&acc)[2][2][4][2], const pg8::Unit& u, int wr, int wc, int fr, int fq) const {
        bf16_t* O = (bf16_t*)(ws + WS_O);
        const int rowb = row0 + u.pn * rpb_ + u.pm * 256 + wr * 64 + fr;
#pragma unroll
        for (int ai = 0; ai < 2; ++ai)
#pragma unroll
            for (int m = 0; m < 4; ++m)
#pragma unroll
                for (int bj = 0; bj < 2; ++bj) {
                    const f32x4 v0 = acc[ai][bj][m][0], v1 = acc[ai][bj][m][1];
                    u32x4 w; w.x = cvt_pk_bf16(v0[0], v0[1]); w.y = cvt_pk_bf16(v0[2], v0[3]); w.z = cvt_pk_bf16(v1[0], v1[1]); w.w = cvt_pk_bf16(v1[2], v1[3]);
                    *(u32x4*)(O + (size_t)(rowb + ai * 128 + m * 16) * DM + 512 + bj * 128 + wc * 32 + 8 * fq) = w;
                }
    }
};

__device__ __forceinline__ void transpose_item(const float* W, int ldw, int k0, int n0, bf16_t* WT, int ldt, int drow0, LAS float* scr, int lane) {
    float v[32];
    const float* src = W + (size_t)(k0 + (lane >> 5)) * ldw + n0 + (lane & 31);
#pragma unroll
    for (int i = 0; i < 32; ++i) v[i] = __builtin_nontemporal_load(src + (size_t)(2 * i) * ldw);
#pragma unroll
    for (int i = 0; i < 32; ++i) scr[(2 * i + (lane >> 5)) * 33 + (lane & 31)] = v[i];
    LDS_WAIT(); asm volatile("" ::: "memory");
    const int c = lane & 7;
#pragma unroll
    for (int j = 0; j < 4; ++j) { const int n = (lane >> 3) + 8 * j; const LAS float* s = scr + (8 * c) * 33 + n;
        u32x4 o; o.x = cvt_pk_bf16(s[0 * 33], s[1 * 33]); o.y = cvt_pk_bf16(s[2 * 33], s[3 * 33]); o.z = cvt_pk_bf16(s[4 * 33], s[5 * 33]); o.w = cvt_pk_bf16(s[6 * 33], s[7 * 33]);
        *(u32x4*)(WT + (size_t)(drow0 + n) * ldt + k0 + 8 * c) = o; }
    LDS_WAIT(); asm volatile("" ::: "memory");
}

__device__ __forceinline__ void mod_items(const Params& p, LAS unsigned char* lds, int l, int first, int stride) {
    const int tid = opaque_tid(), lane = tid & 63, wave = __builtin_amdgcn_readfirstlane(tid >> 6);
    if (first >= 64) return;
    LAS float* sc = (LAS float*)lds;
    LAS float* red = (LAS float*)(lds + 20480);
    for (int i = tid; i < 5 * 1024; i += NTHR) { const int mi = i >> 10, k = i & 1023; const float v = mi == 0 ? p.c_ctx[k] : p.c[(mi - 1) * 1024 + k]; sc[i] = v / (1.f + __expf(-v)); }
    __syncthreads();
    float* mod = (float*)(p.ws + WS_MOD);
    for (int item = first; item < 64; item += stride) {
        const int n0 = item * 144;
        const int ln = lane < 36 ? lane : 35;
        const float* wp = p.ada_w + ((size_t)l * 1024 + wave * 128) * 9216 + n0 + ln * 4;
        f32x4 a0 = {0.f, 0.f, 0.f, 0.f}, a1 = a0, a2 = a0, a3 = a0, a4 = a0;
#pragma unroll 16
        for (int k = 0; k < 128; ++k) { const f32x4 w = __builtin_nontemporal_load((const f32x4*)(wp + (size_t)k * 9216)); const int kk = wave * 128 + k;
            a0 += w * sc[kk]; a1 += w * sc[1024 + kk]; a2 += w * sc[2048 + kk]; a3 += w * sc[3072 + kk]; a4 += w * sc[4096 + kk]; }
        if (lane < 36) {
            *(LAS f32x4*)(red + (wave * 5 + 0) * 144 + lane * 4) = a0; *(LAS f32x4*)(red + (wave * 5 + 1) * 144 + lane * 4) = a1; *(LAS f32x4*)(red + (wave * 5 + 2) * 144 + lane * 4) = a2;
            *(LAS f32x4*)(red + (wave * 5 + 3) * 144 + lane * 4) = a3; *(LAS f32x4*)(red + (wave * 5 + 4) * 144 + lane * 4) = a4; }
        __syncthreads();
        for (int o = tid; o < 720; o += NTHR) { const int mi = o / 144, cc = o % 144; float sum = 0.f;
#pragma unroll
            for (int w = 0; w < 8; ++w) sum += red[(w * 5 + mi) * 144 + cc];
            const int n = n0 + cc; mod[(size_t)(l * 5 + mi) * 9216 + n] = sum + p.ada_b[l * 9216 + n]; }
        __syncthreads();
    }
}
__device__ __forceinline__ void fwi0_items(const Params& p, LAS unsigned char* lds, int l, int sfx, int first, int stride) {
    const int tid = opaque_tid(), lane = tid & 63, wave = __builtin_amdgcn_readfirstlane(tid >> 6);
    LAS float* scr = (LAS float*)(lds + wave * 8704);
    unsigned char* wl = p.ws + WS_W + (size_t)l * W_LAYER;
    constexpr int NIT = 16 * 176 + 44 * 32;
    const int f0 = first + wave; if (f0 >= NIT) return;
    const int nmine = (NIT - 1 - f0) / stride + 1;
#define FW_DEC(j_, S_, LDW_, D_, LDT_) do { int r_ = f0 + (j_) * stride; \
        if (r_ < 16 * 176) { const int kb_ = r_ / 176, n0_ = (r_ % 176) * 32; \
            const int drow_ = n0_ < FF ? (n0_ >> 7) * 256 + (n0_ & 127) : ((n0_ - FF) >> 7) * 256 + 128 + ((n0_ - FF) & 127); \
            S_ = p.ffn_w_in + (size_t)(l * 2 + sfx) * 1024 * NFI + (size_t)(kb_ * 64 + (lane >> 5)) * NFI + n0_ + (lane & 31); LDW_ = NFI; \
            D_ = (bf16_t*)(wl + W_FWI + sfx * SZ_FWI) + (size_t)drow_ * 1024 + kb_ * 64; LDT_ = 1024; } \
        else { r_ -= 16 * 176; const int kb_ = r_ / 32, nb_ = r_ % 32; \
            S_ = p.ffn_w_out + (size_t)(l * 2 + sfx) * FF * 1024 + (size_t)(kb_ * 64 + (lane >> 5)) * 1024 + nb_ * 32 + (lane & 31); LDW_ = 1024; \
            D_ = (bf16_t*)(wl + W_FWO + sfx * SZ_FWO) + (size_t)(nb_ * 32) * FF + kb_ * 64; LDT_ = FF; } } while (0)
#define FW_LOAD(S_, LDW_, V) do { _Pragma("unroll") for (int i = 0; i < 32; ++i) V[i] = __builtin_nontemporal_load((S_) + (size_t)(2 * i) * (LDW_)); } while (0)
#define FW_STORE(D_, LDT_, V) do { _Pragma("unroll") for (int i = 0; i < 32; ++i) scr[(2 * i + (lane >> 5)) * 33 + (lane & 31)] = V[i]; \
        LDS_WAIT(); asm volatile("" ::: "memory"); const int c_ = lane & 7; \
        _Pragma("unroll") for (int j_ = 0; j_ < 4; ++j_) { const int n_ = (lane >> 3) + 8 * j_; const LAS float* q_ = scr + (8 * c_) * 33 + n_; \
            u32x4 o_; o_.x = cvt_pk_bf16(q_[0 * 33], q_[1 * 33]); o_.y = cvt_pk_bf16(q_[2 * 33], q_[3 * 33]); o_.z = cvt_pk_bf16(q_[4 * 33], q_[5 * 33]); o_.w = cvt_pk_bf16(q_[6 * 33], q_[7 * 33]); \
            *(u32x4*)((D_) + (size_t)n_ * (LDT_) + 8 * c_) = o_; } \
        LDS_WAIT(); asm volatile("" ::: "memory"); } while (0)
    const float* sA; bf16_t* dA; int wA_, tA_; const float* sB; bf16_t* dB; int wB_, tB_; float va[32], vb[32];
    FW_DEC(0, sA, wA_, dA, tA_); FW_LOAD(sA, wA_, va);
#pragma unroll 1
    for (int j = 0; j < nmine; j += 2) {
        FW_DEC(min(j + 1, nmine - 1), sB, wB_, dB, tB_); FW_LOAD(sB, wB_, vb);
        FW_STORE(dA, tA_, va);
        FW_DEC(min(j + 2, nmine - 1), sA, wA_, dA, tA_); FW_LOAD(sA, wA_, va);
        if (j + 1 < nmine) FW_STORE(dB, tB_, vb);
    }
#undef FW_DEC
#undef FW_LOAD
#undef FW_STORE
}

__device__ __forceinline__ void prologue(const Params& p, LAS unsigned char* lds, int G) {
    const int tid = opaque_tid(), lane = tid & 63, wave = __builtin_amdgcn_readfirstlane(tid >> 6);
    const int bx = blockIdx.x;
    unsigned char* ws = p.ws;
    mod_items(p, lds, bx >> 6, bx & 63, 64);
    LAS float* tabc = (LAS float*)(lds + 73728); LAS float* tabs = (LAS float*)(lds + 90112);
    for (int i = tid; i < 4096; i += NTHR) { const int j = ((i >> 6) * (i & 63)) & 63; tabc[i] = cospif((float)j * (1.f / 32.f)) * 0.125f; tabs[i] = sinpif((float)j * (1.f / 32.f)) * 0.125f; }
    __syncthreads();
    const int gw = bx * NWAVES + wave, NGW = G * NWAVES;
    LAS float* scr = (LAS float*)(lds + wave * 8704);
    for (int it = gw; it < NLAYER * 64 * 8; it += NGW) {
        const int l = it >> 9, r = (it >> 3) & 63, cq = it & 7;
        unsigned char* wl = ws + WS_W + (size_t)l * W_LAYER;
        const int kb = r >> 2, g = r & 3, k = kb * 64 + lane;
        const float* src = p.w_in + ((size_t)l * 1024 + k) * 2304 + 1536 + g * 64;
        f32x4 w[16];
#pragma unroll
        for (int i = 0; i < 16; ++i) w[i] = *(const f32x4*)(src + 4 * i);
        bf16_t* d1 = (bf16_t*)(wl + W_WIN) + (size_t)(1536 + g * 64) * 1024 + k; bf16_t* d2 = d1 + (size_t)256 * 1024;
        for (int cp = cq * 8; cp < cq * 8 + 8; ++cp) {
            float t1 = 0.f, t2 = 0.f;
#pragma unroll
            for (int c4 = 0; c4 < 16; ++c4) { const f32x4 tc = *(const LAS f32x4*)(tabc + cp * 64 + 4 * c4), ts = *(const LAS f32x4*)(tabs + cp * 64 + 4 * c4); const f32x4 wv = w[c4];
                t1 += (wv[0] * tc[0] + wv[1] * tc[1]) + (wv[2] * tc[2] + wv[3] * tc[3]); t2 += (wv[0] * ts[0] + wv[1] * ts[1]) + (wv[2] * ts[2] + wv[3] * ts[3]); }
            d1[(size_t)cp * 1024] = (bf16_t)(cvt_pk_bf16(t1, t1) & 0xffffu); d2[(size_t)cp * 1024] = (bf16_t)(cvt_pk_bf16(t2, t2) & 0xffffu);
        }
    }
    constexpr int I_FWI = 16 * 176, I_FWO = 44 * 32, I_QKV = 16 * 48, I_G = 16 * 16, I_WO = 16 * 32;
    constexpr int I_REST = 2 * I_FWO + I_QKV + I_G + I_WO, I_REST3 = I_QKV + I_G + I_WO, I_L0 = I_FWI + I_FWO + I_REST3, I_ALL = I_L0 + 3 * I_REST3;
#define TR_DECODE(it_, SRC, LDW, DST, LDT) do { int r_ = (it_), l_ = 0; \
        if (r_ >= I_L0) { r_ -= I_L0; l_ = 1 + r_ / I_REST3; r_ = r_ % I_REST3 + 2 * I_FWI + 2 * I_FWO; } \
        else if (r_ >= I_FWI + I_FWO) r_ += I_FWI + I_FWO; else if (r_ >= I_FWI) r_ += I_FWI; \
        unsigned char* wl_ = ws + WS_W + (size_t)l_ * W_LAYER; \
        if (r_ < 2 * I_FWI) { const int s_ = r_ / I_FWI; r_ %= I_FWI; const int kb_ = r_ / 176, n0_ = (r_ % 176) * 32; \
            const int drow_ = n0_ < FF ? (n0_ >> 7) * 256 + (n0_ & 127) : ((n0_ - FF) >> 7) * 256 + 128 + ((n0_ - FF) & 127); \
            SRC = p.ffn_w_in + (size_t)(l_ * 2 + s_) * 1024 * NFI + (size_t)(kb_ * 64) * NFI + n0_; LDW = NFI; DST = (bf16_t*)(wl_ + W_FWI + s_ * SZ_FWI) + (size_t)drow_ * 1024 + kb_ * 64; LDT = 1024; } \
        else { r_ -= 2 * I_FWI; \
          if (r_ < 2 * I_FWO) { const int s_ = r_ / I_FWO; r_ %= I_FWO; const int kb_ = r_ / 32, nb_ = r_ % 32; \
            SRC = p.ffn_w_out + (size_t)(l_ * 2 + s_) * FF * 1024 + (size_t)(kb_ * 64) * 1024 + nb_ * 32; LDW = 1024; DST = (bf16_t*)(wl_ + W_FWO + s_ * SZ_FWO) + (size_t)(nb_ * 32) * FF + kb_ * 64; LDT = FF; } \
          else { r_ -= 2 * I_FWO; \
            if (r_ < I_QKV) { const int kb_ = r_ / 48, nb_ = r_ % 48; SRC = p.w_in + (size_t)l_ * 1024 * 2304 + (size_t)(kb_ * 64) * 2304 + nb_ * 32; LDW = 2304; DST = (bf16_t*)(wl_ + W_WIN) + (size_t)(nb_ * 32) * 1024 + kb_ * 64; LDT = 1024; } \
            else { r_ -= I_QKV; \
              if (r_ < I_G) { const int kb_ = r_ / 16, nb_ = r_ % 16; SRC = p.w_in + (size_t)l_ * 1024 * 2304 + (size_t)(kb_ * 64) * 2304 + 1792 + nb_ * 32; LDW = 2304; DST = (bf16_t*)(wl_ + W_WIN) + (size_t)(2048 + nb_ * 32) * 1024 + kb_ * 64; LDT = 1024; } \
              else { r_ -= I_G; const int kb_ = r_ / 32, nb_ = r_ % 32; SRC = p.w_out + (size_t)l_ * 1024 * 1024 + (size_t)(kb_ * 64) * 1024 + nb_ * 32; LDW = 1024; DST = (bf16_t*)(wl_ + W_WOUT) + (size_t)(nb_ * 32) * 1024 + kb_ * 64; LDT = 1024; } } } } } while (0)
#define TR_LOAD(SRC, LDW, V) do { const float* s_ = (SRC) + (size_t)(lane >> 5) * (LDW) + (lane & 31); _Pragma("unroll") for (int i = 0; i < 32; ++i) V[i] = __builtin_nontemporal_load(s_ + (size_t)(2 * i) * (LDW)); } while (0)
#define TR_STORE(DST, LDT, V) do { _Pragma("unroll") for (int i = 0; i < 32; ++i) scr[(2 * i + (lane >> 5)) * 33 + (lane & 31)] = V[i]; \
        LDS_WAIT(); asm volatile("" ::: "memory"); const int c_ = lane & 7; \
        _Pragma("unroll") for (int j = 0; j < 4; ++j) { const int n_ = (lane >> 3) + 8 * j; const LAS float* q_ = scr + (8 * c_) * 33 + n_; \
            u32x4 o_; o_.x = cvt_pk_bf16(q_[0 * 33], q_[1 * 33]); o_.y = cvt_pk_bf16(q_[2 * 33], q_[3 * 33]); o_.z = cvt_pk_bf16(q_[4 * 33], q_[5 * 33]); o_.w = cvt_pk_bf16(q_[6 * 33], q_[7 * 33]); \
            *(u32x4*)((DST) + (size_t)n_ * (LDT) + 8 * c_) = o_; } \
        LDS_WAIT(); asm volatile("" ::: "memory"); } while (0)
    if (gw < I_ALL) {
        const int nmine = (I_ALL - 1 - gw) / NGW + 1;
        const float* sA; int ldwA; bf16_t* dA; int ldtA; const float* sB; int ldwB; bf16_t* dB; int ldtB;
        float va[32], vb[32];
        TR_DECODE(gw, sA, ldwA, dA, ldtA); TR_LOAD(sA, ldwA, va);
#pragma unroll 1
        for (int j = 0; j < nmine; j += 2) {
            { const int jn = min(j + 1, nmine - 1); TR_DECODE(gw + jn * NGW, sB, ldwB, dB, ldtB); TR_LOAD(sB, ldwB, vb); }
            TR_STORE(dA, ldtA, va);
            { const int jn = min(j + 2, nmine - 1); TR_DECODE(gw + jn * NGW, sA, ldwA, dA, ldtA); TR_LOAD(sA, ldwA, va); }
            if (j + 1 < nmine) TR_STORE(dB, ldtB, vb);
        }
    }
#undef TR_DECODE
#undef TR_LOAD
#undef TR_STORE
    const int gt = bx * NTHR + tid, NGT = G * NTHR;
    {   bf16_t* dfts = (bf16_t*)(ws + WS_DFTS);
        for (int e = gt; e < 1024 * 2048 / 8; e += NGT) { const int np = e >> 8, k0 = (e & 255) * 8; float v[8];
#pragma unroll
            for (int i = 0; i < 8; ++i) { const int k = k0 + i; const int j = (np * (k & 1023)) & 1023; const float a = (float)j * (1.f / 512.f); v[i] = (k < 1024 ? cospif(a) : -sinpif(a)) * 0.03125f; }
            u32x4 w; w.x = cvt_pk_bf16(v[0], v[1]); w.y = cvt_pk_bf16(v[2], v[3]); w.z = cvt_pk_bf16(v[4], v[5]); w.w = cvt_pk_bf16(v[6], v[7]); *(u32x4*)(dfts + (size_t)e * 8) = w; }
        bf16_t* dftp = (bf16_t*)(ws + WS_DFTP);
        for (int e = gt; e < 256 * 512 / 8; e += NGT) { const int np = e >> 6, k0 = (e & 63) * 8; float v[8];
#pragma unroll
            for (int i = 0; i < 8; ++i) { const int k = k0 + i; const int j = (np * (k & 255)) & 255; const float a = (float)j * (1.f / 128.f); v[i] = (k < 256 ? cospif(a) : -sinpif(a)) * 0.0625f; }
            u32x4 w; w.x = cvt_pk_bf16(v[0], v[1]); w.y = cvt_pk_bf16(v[2], v[3]); w.z = cvt_pk_bf16(v[4], v[5]); w.w = cvt_pk_bf16(v[6], v[7]); *(u32x4*)(dftp + (size_t)e * 8) = w; }
        bf16_t* gw16 = (bf16_t*)(ws + WS_GW);
        for (int e = gt; e < 4 * 4 * 128 * 128 / 8; e += NGT) { const float* sp = p.gmlp_w + (size_t)e * 8; const f32x4 v0 = *(const f32x4*)sp, v1 = *(const f32x4*)(sp + 4);
            u32x4 w; w.x = cvt_pk_bf16(v0[0], v0[1]); w.y = cvt_pk_bf16(v0[2], v0[3]); w.z = cvt_pk_bf16(v1[0], v1[1]); w.w = cvt_pk_bf16(v1[2], v1[3]); *(u32x4*)(gw16 + (size_t)e * 8) = w; }
        bf16_t* ck = (bf16_t*)(ws + WS_CK);
        for (int e = gt; e < 4 * 4 * 8 * 256 * 8; e += NGT) { const int d8 = (e & 7) * 8, pp_ = (e >> 3) & 255, h = (e >> 11) & 7, b = (e >> 14) & 3, l = e >> 16;
            const float* sp = p.cache_k + ((size_t)((b * 4 + l) * 256 + pp_)) * 512 + h * 64 + d8; const f32x4 v0 = __builtin_nontemporal_load((const f32x4*)sp), v1 = __builtin_nontemporal_load((const f32x4*)(sp + 4));
            u32x4 w; w.x = cvt_pk_bf16(v0[0], v0[1]); w.y = cvt_pk_bf16(v0[2], v0[3]); w.z = cvt_pk_bf16(v1[0], v1[1]); w.w = cvt_pk_bf16(v1[2], v1[3]); *(u32x4*)(ck + (size_t)e * 8) = w; }
        bf16_t* cvt = (bf16_t*)(ws + WS_CVT);
        for (int e = gt; e < 4 * 4 * 8 * 8 * 64 * 4; e += NGT) { const int pg = e & 3, d = (e >> 2) & 63, chk = (e >> 8) & 7, h = (e >> 11) & 7, b = (e >> 14) & 3, l = e >> 16;
            const float* sp = p.cache_v + ((size_t)((b * 4 + l) * 256 + chk * 32 + pg * 8)) * 512 + h * 64 + d; float v[8];
#pragma unroll
            for (int i = 0; i < 8; ++i) v[i] = __builtin_nontemporal_load(sp + (size_t)i * 512);
            u32x4 w; w.x = cvt_pk_bf16(v[0], v[1]); w.y = cvt_pk_bf16(v[2], v[3]); w.z = cvt_pk_bf16(v[4], v[5]); w.w = cvt_pk_bf16(v[6], v[7]);
            *(u32x4*)(cvt + (size_t)e * 8) = w; }
    }
}

__device__ __forceinline__ void norm_phase(const Params& p, int G, bool first, bool has_prev, bool has_next, float coef, bool dummy,
                                           const float* modp_gate  , const float* npost, const float* modn  , const float* npre) {
    const int tid = opaque_tid(), lane = tid & 63, wave = tid >> 6;
    const int gw = opaque_bx() * NWAVES + wave, NGW = G * NWAVES;
    const float* X = p.out; float* Xo = dummy ? (float*)(p.ws + WS_END) : p.out; const bf16_t* Y0 = (const bf16_t*)(p.ws + WS_Y); const bf16_t* Y1 = Y0 + (size_t)MTOK * DM; bf16_t* H = dummy ? (bf16_t*)(p.ws + WS_END + 32 * MiB) : (bf16_t*)(p.ws + WS_H);
    for (int row = gw; row < MTOK; row += NGW) {
        const int mi = row < MPR ? 0 : 1 + ((row - MPR) >> 10);
        const float* xs = first ? (row < MPR ? p.x_prompt + (size_t)row * DM : p.x_sample + (size_t)(row - MPR) * DM) : X + (size_t)row * DM;
        f32x4 x[4], gt[4], npo[4], sh[4], scl[4], npr[4]; u32x2 ya[4], yb[4];
#pragma unroll
        for (int j = 0; j < 4; ++j) x[j] = first ? __builtin_nontemporal_load((const f32x4*)(xs + 4 * lane + 256 * j)) : *(const f32x4*)(xs + 4 * lane + 256 * j);
        if (has_prev) {
#pragma unroll
            for (int j = 0; j < 4; ++j) { ya[j] = *(const u32x2*)(Y0 + (size_t)row * DM + 4 * lane + 256 * j); yb[j] = *(const u32x2*)(Y1 + (size_t)row * DM + 4 * lane + 256 * j);
                gt[j] = *(const f32x4*)(modp_gate + (size_t)mi * 9216 + 4 * lane + 256 * j); npo[j] = *(const f32x4*)(npost + 4 * lane + 256 * j); }
        }
        if (has_next) {
#pragma unroll
            for (int j = 0; j < 4; ++j) { sh[j] = *(const f32x4*)(modn + (size_t)mi * 9216 + 4 * lane + 256 * j); scl[j] = *(const f32x4*)(modn + (size_t)mi * 9216 + 1024 + 4 * lane + 256 * j);
                npr[j] = *(const f32x4*)(npre + 4 * lane + 256 * j); }
        }
        if (has_prev) {
            f32x4 y[4]; float ss = 0.f;
#pragma unroll
            for (int j = 0; j < 4; ++j) {
                y[j][0] = __uint_as_float(ya[j].x << 16) + __uint_as_float(yb[j].x << 16); y[j][1] = __uint_as_float(ya[j].x & 0xffff0000u) + __uint_as_float(yb[j].x & 0xffff0000u);
                y[j][2] = __uint_as_float(ya[j].y << 16) + __uint_as_float(yb[j].y << 16); y[j][3] = __uint_as_float(ya[j].y & 0xffff0000u) + __uint_as_float(yb[j].y & 0xffff0000u);
                ss += (y[j][0] * y[j][0] + y[j][1] * y[j][1]) + (y[j][2] * y[j][2] + y[j][3] * y[j][3]); }
            const float rs = coef * rsqrtf(wave_sum(ss) * (1.f / DM) + EPS);
#pragma unroll
            for (int j = 0; j < 4; ++j) x[j] += gt[j] * (y[j] * rs * npo[j]);
        }
        u32x2 hw[4];
        if (has_next) {
            float ss = 0.f;
#pragma unroll
            for (int j = 0; j < 4; ++j) ss += (x[j][0] * x[j][0] + x[j][1] * x[j][1]) + (x[j][2] * x[j][2] + x[j][3] * x[j][3]);
            const float rs = rsqrtf(wave_sum(ss) * (1.f / DM) + EPS);
#pragma unroll
            for (int j = 0; j < 4; ++j) { const f32x4 h = (x[j] * rs * npr[j]) * (scl[j] + 1.f) + sh[j]; hw[j].x = cvt_pk_bf16(h[0], h[1]); hw[j].y = cvt_pk_bf16(h[2], h[3]); }
        }
        if (has_prev || first) {
#pragma unroll
            for (int j = 0; j < 4; ++j) *(f32x4*)(Xo + (size_t)row * DM + 4 * lane + 256 * j) = x[j];
        }
        if (has_next) {
#pragma unroll
            for (int j = 0; j < 4; ++j) *(u32x2*)(H + (size_t)row * DM + 4 * lane + 256 * j) = hw[j];
        }
    }
}

#define MFMA16(a, b, c) __builtin_amdgcn_mfma_f32_16x16x32_bf16(a, b, c, 0, 0, 0)
struct AttnCtx { const bf16_t *Kb, *VT, *CKl, *CVTl; int nbr, bh, rlo, nloc, cb, ka, fr, fq; };
__device__ __forceinline__ void attn_load(const AttnCtx& c, int ch, bf16x8 (&kf)[4], bf16x8 (&vf)[4]) {
    const bf16_t* kbase; const bf16_t* vbase; int vpitch;
    if (c.nbr) {
        if (ch < c.nloc) { const int arow = c.rlo + ch; kbase = c.Kb + 2097152 + (size_t)(c.bh * 1024 + arow * 64 + c.cb) * 64; vbase = c.VT + 2097152 + (size_t)(c.bh * 16 + arow) * 4096 + c.cb; vpitch = 64; }
        else { const int cc = min(ch - c.nloc, 7); kbase = c.CKl + (size_t)(c.bh * 256 + cc * 32) * 64; vbase = c.CVTl + (size_t)(c.bh * 8 + cc) * 2048; vpitch = 32; }
    } else { kbase = c.Kb + (size_t)(c.bh * 256 + ch * 32) * 64; vbase = c.VT + (size_t)(c.bh * 8 + ch) * 2048; vpitch = 32; }
    const bf16_t* kp0 = kbase + (size_t)c.ka * 64 + c.fq * 8; const bf16_t* kp1 = kp0 + 4 * 64;
    kf[0] = *(const bf16x8*)kp0; kf[1] = *(const bf16x8*)(kp0 + 32); kf[2] = *(const bf16x8*)kp1; kf[3] = *(const bf16x8*)(kp1 + 32);
#pragma unroll
    for (int dt = 0; dt < 4; ++dt) vf[dt] = *(const bf16x8*)(vbase + (size_t)(dt * 16 + c.fr) * vpitch + c.fq * 8);
}
struct AttnTile { bf16x8 q0, q1; f32x4 o[4]; float m, l; };
__device__ __forceinline__ void attn_step(AttnTile& t, const bf16x8 (&kf)[4], const bf16x8 (&vf)[4], bool local, const LAS float* brow, int kc0, int qc, int cs) {
    f32x4 s0 = {0.f, 0.f, 0.f, 0.f}, s1 = s0;
    s0 = MFMA16(kf[0], t.q0, s0); s0 = MFMA16(kf[1], t.q1, s0); s1 = MFMA16(kf[2], t.q0, s1); s1 = MFMA16(kf[3], t.q1, s1);
    float s[8] = {s0[0], s0[1], s0[2], s0[3], s1[0], s1[1], s1[2], s1[3]};
    if (local) {
        float bias[8];
#pragma unroll
        for (int i = 0; i < 8; ++i) { const int kc = kc0 + i; const bool valid = kc >= cs && kc < cs + 16; bias[i] = brow[valid ? kc : qc]; }
        asm volatile("" : "+v"(bias[0]), "+v"(bias[1]), "+v"(bias[2]), "+v"(bias[3]), "+v"(bias[4]), "+v"(bias[5]), "+v"(bias[6]), "+v"(bias[7]));
#pragma unroll
        for (int i = 0; i < 8; ++i) { const int kc = kc0 + i; const bool valid = kc >= cs && kc < cs + 16; s[i] = valid ? s[i] + bias[i] : -1e30f; }
    }
    float mx = fmaxf(fmaxf(fmaxf(s[0], s[1]), fmaxf(s[2], s[3])), fmaxf(fmaxf(s[4], s[5]), fmaxf(s[6], s[7])));
    mx = fmaxf(mx, __shfl_xor(mx, 16)); mx = fmaxf(mx, __shfl_xor(mx, 32));
    const float mnew = fmaxf(t.m, mx); const float alpha = __expf(t.m - mnew); t.m = mnew;
    float ps = 0.f;
#pragma unroll
    for (int i = 0; i < 8; ++i) { s[i] = __expf(s[i] - mnew); ps += s[i]; }
    t.l = t.l * alpha + ps;
    union { u32x4 w; bf16x8 v; } pb; pb.w.x = cvt_pk_bf16(s[0], s[1]); pb.w.y = cvt_pk_bf16(s[2], s[3]); pb.w.z = cvt_pk_bf16(s[4], s[5]); pb.w.w = cvt_pk_bf16(s[6], s[7]);
#pragma unroll
    for (int dt = 0; dt < 4; ++dt) { t.o[dt] = t.o[dt] * alpha; t.o[dt] = MFMA16(vf[dt], pb.v, t.o[dt]); }
}
struct AttnPair { int nbr, nloc, dB, cb, fq, qc, cs; const LAS float *btA, *btB; };
__device__ __forceinline__ void attn_step2(const AttnPair& P, int ch, AttnTile& A, AttnTile& B, const bf16x8 (&kf)[4], const bf16x8 (&vf)[4]) {
    const int kc0 = P.cb + P.fq * 8;
    if (P.nbr) {
        if (ch < P.nloc) {
            if (ch < 8) attn_step(A, kf, vf, true, P.btA + ch * 31 + 15 - P.qc, kc0, P.qc, P.cs);
            if (ch >= P.dB) attn_step(B, kf, vf, true, P.btB + (ch - P.dB) * 31 + 15 - P.qc, kc0, P.qc, P.cs);
        } else if (ch < P.nloc + 8) { attn_step(A, kf, vf, false, nullptr, kc0, P.qc, P.cs); attn_step(B, kf, vf, false, nullptr, kc0, P.qc, P.cs); }
    } else { attn_step(A, kf, vf, false, nullptr, kc0, P.qc, P.cs); attn_step(B, kf, vf, false, nullptr, kc0, P.qc, P.cs); }
}
__device__ __forceinline__ void attn_finish(AttnTile& t, bf16_t* op) {
    float ls = t.l; ls += __shfl_xor(ls, 16); ls += __shfl_xor(ls, 32);
    const float inv = __builtin_amdgcn_rcpf(ls);
#pragma unroll
    for (int dt = 0; dt < 4; ++dt) { u32x2 w; w.x = cvt_pk_bf16(t.o[dt][0] * inv, t.o[dt][1] * inv); w.y = cvt_pk_bf16(t.o[dt][2] * inv, t.o[dt][3] * inv); *(u32x2*)(op + dt * 16) = w; }
}
__device__ __forceinline__ void attn_wave_unit(int u2, int l, unsigned char* ws, const float* rpb, LAS unsigned char* wl, int lane) {
    const bf16_t* Qb = (const bf16_t*)(ws + WS_Q); bf16_t* O = (bf16_t*)(ws + WS_O);
    AttnCtx c; c.Kb = (const bf16_t*)(ws + WS_K); c.VT = (const bf16_t*)(ws + WS_VT);
    c.CKl = (const bf16_t*)(ws + WS_CK) + (size_t)l * 524288; c.CVTl = (const bf16_t*)(ws + WS_CVT) + (size_t)l * 524288;
    const int fr = lane & 15, fq = lane >> 4; c.fr = fr; c.fq = fq; c.ka = (fr >> 2) * 8 + (fr & 3);
    c.nbr = u2 < 1024;
    AttnPair P; P.nbr = c.nbr; P.fq = fq;
    int h, qrowA, qrowB, nch, rA = 0, rsA = 0, rsB = 0, jb = 0;
    if (c.nbr) { const int b = u2 >> 8; h = (u2 >> 5) & 7; const int rp = (u2 >> 2) & 7; jb = u2 & 3; c.bh = b * 8 + h; rA = 2 * rp;
        rsA = min(max(rA - 4, 0), 8); rsB = min(max(rA - 3, 0), 8); c.rlo = rsA; c.nloc = rsB - rsA + 8; c.cb = min(max(16 * jb - 8, 0), 32);
        qrowA = MPR + b * 1024 + rA * 64 + jb * 16; qrowB = qrowA + 64; nch = (c.nloc + 8 + 1) & ~1; }
    else { const int v = u2 - 1024; const int b = v >> 6; h = (v >> 3) & 7; c.bh = b * 8 + h; c.rlo = 0; c.nloc = 0; c.cb = 0; qrowA = b * 256 + (v & 7) * 32; qrowB = qrowA + 16; nch = 8; }
    P.nloc = c.nloc; P.dB = rsB - rsA; P.cb = c.cb; P.qc = jb * 16 + fr; P.cs = min(max(P.qc - 8, 0), 48);
    LAS float* btab = (LAS float*)wl;
    P.btA = btab; P.btB = btab + 256;
    AttnTile A, B;
    { const bf16_t* qa = Qb + (size_t)(qrowA + fr) * 512 + h * 64 + fq * 8; const bf16_t* qb = Qb + (size_t)(qrowB + fr) * 512 + h * 64 + fq * 8;
      A.q0 = *(const bf16x8*)qa; A.q1 = *(const bf16x8*)(qa + 32); B.q0 = *(const bf16x8*)qb; B.q1 = *(const bf16x8*)(qb + 32); }
    bf16x8 kA[4], vA[4], kB[4], vB[4];
    attn_load(c, 0, kA, vA);
    if (c.nbr) { const float* ra = rpb + ((size_t)l * 8 + h) * 15 * 31 + (rsA - rA + 7) * 31; const float* rb = rpb + ((size_t)l * 8 + h) * 15 * 31 + (rsB - rA - 1 + 7) * 31;
        float t0 = ra[lane], t1 = ra[64 + lane], t2 = ra[128 + lane], t3 = ra[min(192 + lane, 247)], t4 = rb[lane], t5 = rb[64 + lane], t6 = rb[128 + lane], t7 = rb[min(192 + lane, 247)];
        btab[lane] = t0; btab[64 + lane] = t1; btab[128 + lane] = t2; if (lane < 56) btab[192 + lane] = t3;
        btab[256 + lane] = t4; btab[320 + lane] = t5; btab[384 + lane] = t6; if (lane < 56) btab[448 + lane] = t7; }
#pragma unroll
    for (int i = 0; i < 4; ++i) { A.o[i] = (f32x4){0.f, 0.f, 0.f, 0.f}; B.o[i] = (f32x4){0.f, 0.f, 0.f, 0.f}; }
    A.m = -INFINITY; B.m = -INFINITY; A.l = 0.f; B.l = 0.f;
#pragma unroll 1
    for (int ch = 0; ch < nch; ch += 2) {
        attn_load(c, ch + 1, kB, vB);
        attn_step2(P, ch, A, B, kA, vA);
        attn_load(c, min(ch + 2, nch - 1), kA, vA);
        attn_step2(P, ch + 1, A, B, kB, vB);
    }
    attn_finish(A, O + (size_t)(qrowA + fr) * DM + h * 64 + fq * 4);
    attn_finish(B, O + (size_t)(qrowB + fr) * DM + h * 64 + fq * 4);
}

__device__ __forceinline__ void gmlp_wave_unit(int u, int phalf, int l, unsigned char* ws, const float* gn_, const float* gb_, LAS unsigned char* wl, int lane) {
    const bf16_t* Gb = (const bf16_t*)(ws + WS_G); bf16_t* O = (bf16_t*)(ws + WS_O);
    const int fr = lane & 15, fq = lane >> 4;
    const int ck = u >> 2, g = u & 3, row0 = ck * 128, p0 = 4 * phalf;
    const float* gn = gn_ + l * 256; const float* gbias = gb_ + l * 512;
    const bf16_t* gw = (const bf16_t*)(ws + WS_GW) + ((size_t)(l * 4 + g) * 128) * 128;
    LAS bf16_t* vnT = (LAS bf16_t*)wl;
    constexpr int VP = 136;
    u32x4 raw[2][8]; bf16x8 wf[4][4]; u32x2 uu[4][4]; float gbv[4]; f32x4 gnv[4];
#pragma unroll
    for (int half = 0; half < 2; ++half) { const bf16_t* src = Gb + (size_t)(row0 + half * 64 + lane) * 512 + 256 + g * 64;
#pragma unroll
        for (int i = 0; i < 8; ++i) raw[half][i] = *(const u32x4*)(src + 8 * i); }
#define GM_LO(w_) __uint_as_float((w_) << 16)
#define GM_HI(w_) __uint_as_float((w_) & 0xffff0000u)
#pragma unroll
    for (int half = 0; half < 2; ++half) {
        const int t = half * 64 + lane;
        float mu = 0.f;
#pragma unroll
        for (int i = 0; i < 8; ++i)
#pragma unroll
            for (int j = 0; j < 4; ++j) mu += GM_LO(raw[half][i][j]) + GM_HI(raw[half][i][j]);
        mu *= (1.f / 64.f);
        float var = 0.f;
#pragma unroll
        for (int i = 0; i < 8; ++i)
#pragma unroll
            for (int j = 0; j < 4; ++j) { const float a_ = GM_LO(raw[half][i][j]) - mu, b_ = GM_HI(raw[half][i][j]) - mu; var += a_ * a_ + b_ * b_; }
        const float rsd = rsqrtf(var * (1.f / 64.f) + EPS);
#pragma unroll
        for (int i = 0; i < 8; ++i)
#pragma unroll
            for (int j = 0; j < 4; ++j) { const float a_ = (GM_LO(raw[half][i][j]) - mu) * rsd, b_ = (GM_HI(raw[half][i][j]) - mu) * rsd;
                const unsigned pk = cvt_pk_bf16(a_, b_); vnT[(8 * i + 2 * j) * VP + t] = (bf16_t)(pk & 0xffffu); vnT[(8 * i + 2 * j + 1) * VP + t] = (bf16_t)(pk >> 16); }
    }
#undef GM_LO
#undef GM_HI
    LDS_WAIT(); asm volatile("" ::: "memory");
#pragma unroll
    for (int pt = 0; pt < 4; ++pt) { const bf16_t* wp = gw + (size_t)((p0 + pt) * 16 + fr) * 128 + fq * 8;
#pragma unroll
        for (int ks = 0; ks < 4; ++ks) wf[pt][ks] = *(const bf16x8*)(wp + ks * 32);
#pragma unroll
        for (int ct = 0; ct < 4; ++ct) uu[pt][ct] = *(const u32x2*)(Gb + (size_t)(row0 + (p0 + pt) * 16 + fr) * 512 + g * 64 + ct * 16 + fq * 4);
        gbv[pt] = gbias[g * 128 + (p0 + pt) * 16 + fr]; }
#pragma unroll
    for (int ct = 0; ct < 4; ++ct) gnv[ct] = *(const f32x4*)(gn + g * 64 + ct * 16 + fq * 4);
#pragma unroll
    for (int pt = 0; pt < 4; ++pt) {
        const int row_ = row0 + (p0 + pt) * 16 + fr; const float GB = gbv[pt];
#pragma unroll
        for (int ct = 0; ct < 4; ++ct) { f32x4 acc = {0.f, 0.f, 0.f, 0.f};
#pragma unroll
            for (int ks = 0; ks < 4; ++ks) { const bf16x8 a_ = *(const LAS bf16x8*)(vnT + (ct * 16 + fr) * VP + ks * 32 + fq * 8); acc = MFMA16(a_, wf[pt][ks], acc); }
            const u32x2 uw = uu[pt][ct]; const f32x4 gq = gnv[ct];
            const float u0 = __uint_as_float(uw.x << 16), u1 = __uint_as_float(uw.x & 0xffff0000u), u2 = __uint_as_float(uw.y << 16), u3 = __uint_as_float(uw.y & 0xffff0000u);
            u32x2 w_; w_.x = cvt_pk_bf16(u0 * (acc[0] * gq[0] + GB), u1 * (acc[1] * gq[1] + GB)); w_.y = cvt_pk_bf16(u2 * (acc[2] * gq[2] + GB), u3 * (acc[3] * gq[3] + GB));
            *(u32x2*)(O + (size_t)row_ * DM + 768 + g * 64 + ct * 16 + fq * 4) = w_; }
    }
    LDS_WAIT(); asm volatile("" ::: "memory");
}

#define XB_TMO      128
#define XB_XCNT(j)  (256  + 64 * (j))
#define XB_XSUB(j)  (1280 + 64 * (j))
#define XB_XGEN(j)  (2304 + 64 * (j))
#define XB_TOP      3328
#define XB_TOPGEN   3392
#define XCD_BAR_WORDS 3456
#define XB_SPIN_CAP (1u << 18)
__device__ __forceinline__ unsigned xb_ld(unsigned* p)              { return __hip_atomic_load(p, __ATOMIC_RELAXED, __HIP_MEMORY_SCOPE_AGENT); }
__device__ __forceinline__ unsigned xb_add(unsigned* p, unsigned v) { return __hip_atomic_fetch_add(p, v, __ATOMIC_RELAXED, __HIP_MEMORY_SCOPE_AGENT); }
__device__ __forceinline__ unsigned xb_xcc_id() { return (unsigned)__builtin_amdgcn_s_getreg((3 << 11) | 20) & 0xFu; }
#define XB_SPIN(cond, bar) do { unsigned _sp = 0; while (cond) { __builtin_amdgcn_s_sleep(1); \
    if ((++_sp & 255u) == 0u) { if (xb_ld(&(bar)[XB_TMO])) break; if (_sp > XB_SPIN_CAP) { atomicAdd(&(bar)[XB_TMO], 1u); break; } } } } while (0)
__device__ __forceinline__ void xcd_barrier_complete(unsigned* bar, unsigned x, unsigned& nloc, unsigned& nx) {
    const unsigned G = gridDim.x * gridDim.y * gridDim.z;
    unsigned sum, cnt, mine, sp = 0u;
    for (;;) {
        sum = 0u; cnt = 0u; mine = 0u;
#pragma unroll
        for (unsigned j = 0; j < 16; ++j) { const unsigned c = xb_ld(&bar[XB_XCNT(j)]); sum += c; cnt += (c > 0u) ? 1u : 0u; mine = (j == x) ? c : mine; }
        if (sum == G) break;
        __builtin_amdgcn_s_sleep(1);
        if ((++sp & 255u) == 0u) { if (xb_ld(&bar[XB_TMO])) break; if (sp > XB_SPIN_CAP) { atomicAdd(&bar[XB_TMO], 1u); break; } }
    }
    nloc = mine > 0u ? mine : 1u; nx = cnt > 0u ? cnt : 1u;
}
__device__ __forceinline__ void xcd_barrier(unsigned* bar, volatile LAS unsigned* st) {
    asm volatile("s_waitcnt vmcnt(0)" ::: "memory");
    __syncthreads();
    if (opaque_tid() == 0) {
        __builtin_amdgcn_s_waitcnt(0);
        const unsigned x = xb_xcc_id();
        unsigned nloc = st[0], nx = st[1];
        if (nloc == 0u) { xcd_barrier_complete(bar, x, nloc, nx); st[0] = nloc; st[1] = nx; }
        const unsigned old = xb_add(&bar[XB_XSUB(x)], 1u);
        const unsigned gen = old / nloc;
        if (old + 1u == (gen + 1u) * nloc) {
            __builtin_amdgcn_fence(__ATOMIC_RELEASE, "agent");
            asm volatile("s_waitcnt vmcnt(0)" ::: "memory");
            const unsigned og = xb_add(&bar[XB_TOP], 1u);
            const unsigned tg = og / nx;
            if (og + 1u == (tg + 1u) * nx) xb_add(&bar[XB_TOPGEN], 1u);
            else XB_SPIN(xb_ld(&bar[XB_TOPGEN]) == tg, bar);
            __builtin_amdgcn_fence(__ATOMIC_ACQUIRE, "agent");
            xb_add(&bar[XB_XGEN(x)], 1u);
            asm volatile("s_waitcnt vmcnt(0)" ::: "memory");
        } else {
            XB_SPIN(xb_ld(&bar[XB_XGEN(x)]) == gen, bar);
            __builtin_amdgcn_fence(__ATOMIC_ACQUIRE, "agent");
            asm volatile("s_waitcnt vmcnt(0)" ::: "memory");
        }
    }
    __syncthreads();
}
constexpr int CW_BAR = 4096;
constexpr int LDS_BARW = 147200;

#ifndef PROBE_SYNC
#define PROBE_SYNC 0
#endif
#ifndef PROBE_MIX
#define PROBE_MIX 0
#endif
#ifndef PROBE_PRO
#define PROBE_PRO 0
#endif
#ifndef PROBE_NORM
#define PROBE_NORM 0
#endif
#ifndef PROBE_G
#define PROBE_G 0
#endif
#define XSYNC() xcd_barrier((unsigned*)(pp->ws + WS_CTL) + CW_BAR, (volatile LAS unsigned*)(lds + LDS_BARW))
#define GSYNC() do { LAUNDER(pp); XSYNC(); if (PROBE_SYNC) { LAUNDER(pp); XSYNC(); } } while (0)
#if defined(__HIP_DEVICE_COMPILE__)
typedef const __attribute__((address_space(4))) Params* PP;
#else
typedef const Params* PP;
#endif
#define LAUNDER(pp) asm volatile("" : "+s"(pp) :: "memory")
#define LOADP(pp) (*(const Params*)(pp))

__device__ __forceinline__ void norm_step(PP pp, int l, int sub, bool dummy = false) {
    const Params p = *pp;
    const int G = gridDim.x;
    const float* mod = (const float*)(p.ws + WS_MOD);
    if (sub == 0) { const int lp = l > 0 ? l - 1 : 0;
        norm_phase(p, G, l == 0, l > 0, true, 0.5f, dummy, mod + (size_t)lp * 5 * 9216 + 8 * 1024, p.norm_post + (lp * 3 + 2) * DM, mod + (size_t)l * 5 * 9216, p.norm_pre + (l * 3 + 0) * DM); }
    else if (sub == 1) norm_phase(p, G, false, true, true, 0.5f, dummy, mod + (size_t)l * 5 * 9216 + 2 * 1024, p.norm_post + (l * 3 + 0) * DM, mod + (size_t)l * 5 * 9216 + 3 * 1024, p.norm_pre + (l * 3 + 1) * DM);
    else if (sub == 2) norm_phase(p, G, false, true, true, 1.0f, dummy, mod + (size_t)l * 5 * 9216 + 5 * 1024, p.norm_post + (l * 3 + 1) * DM, mod + (size_t)l * 5 * 9216 + 6 * 1024, p.norm_pre + (l * 3 + 2) * DM);
    else norm_phase(p, G, false, true, false, 0.5f, dummy, mod + (size_t)3 * 5 * 9216 + 8 * 1024, p.norm_post + (3 * 3 + 2) * DM, mod, p.norm_pre);
}

__global__ void __launch_bounds__(NTHR, 2) fwd_kernel(Params p_unused) {
    extern __shared__ __attribute__((aligned(16))) unsigned char lds_raw[];
    LAS unsigned char* lds = (LAS unsigned char*)lds_raw;
    cg::grid_group grid = cg::this_grid();
    PP pp = (PP)__builtin_amdgcn_kernarg_segment_ptr();
    LAUNDER(pp);
    if (threadIdx.x == 0) { ((volatile LAS unsigned*)(lds + LDS_BARW))[0] = 0u; ((volatile LAS unsigned*)(lds + LDS_BARW))[1] = 0u;
        (void)xb_add((unsigned*)(pp->ws + WS_CTL) + CW_BAR + XB_XCNT(xb_xcc_id()), 1u); }
    __syncthreads();
    { const Params p = *pp; prologue(p, lds, gridDim.x); }
    if (PROBE_PRO) { GSYNC(); LAUNDER(pp); const Params p = *pp; prologue(p, lds, gridDim.x); }
    GSYNC();
    if (gridDim.y == 0xFFFFu) grid.sync();

#pragma unroll 1
    for (int l = 0; l < NLAYER; ++l) {
        LAUNDER(pp);
        if (PROBE_NORM) { norm_step(pp, l, 0, true); LAUNDER(pp); }
        norm_step(pp, l, 0);
        GSYNC();
#pragma unroll 1
        for (int s = 0; s < 2; ++s) {
            LAUNDER(pp);
#pragma unroll 1
            for (int rep = 0; rep <= ((PROBE_G & 1) ? 1 : 0); ++rep) {
                LAUNDER(pp);
                unsigned char* ws = pp->ws; const unsigned char* wl = ws + WS_W + (size_t)l * W_LAYER;
                pg8::Gemm g{(const bf16_t*)(ws + WS_H), (const bf16_t*)(wl + W_FWI + s * SZ_FWI)}; pg8::StaticOrder S; S.init(MTOK / 256, NFI / 256, 1, gridDim.x, opaque_bx());
                EpiSwiglu E{ws};
                pg8::gemm_phase<DM, DM, DM, EpiSwiglu, pg8::StaticOrder>(lds, g, S, E);
                if (rep == 0 && opaque_bx() >= 192 && (s == 0 || l + 1 < NLAYER)) {
                    LAUNDER(pp); const Params p = *pp;
                    fwi0_items(p, lds, s == 0 ? l : l + 1, s == 0 ? 1 : 0, (opaque_bx() - 192) * NWAVES, 64 * NWAVES);
                }
            }
            GSYNC();
            LAUNDER(pp);
#pragma unroll 1
            for (int rep = 0; rep <= ((PROBE_G & 2) ? 1 : 0); ++rep) {
                LAUNDER(pp);
                unsigned char* ws = pp->ws; const unsigned char* wl = ws + WS_W + (size_t)l * W_LAYER;
                pg8::Gemm g{(const bf16_t*)(ws + WS_A2), (const bf16_t*)(wl + W_FWO + s * SZ_FWO)}; pg8::StaticOrder S; S.init(MTOK / 256, DM / 256, 2, gridDim.x, opaque_bx());
                EpiF32 E{ws};
                pg8::gemm_phase<FF, FF, FF / 2, EpiF32, pg8::StaticOrder>(lds, g, S, E);
            }
            GSYNC();
            if (s == 1) break;
            LAUNDER(pp);
            if (PROBE_NORM) { norm_step(pp, l, 1, true); LAUNDER(pp); }
            norm_step(pp, l, 1);
            GSYNC();
            LAUNDER(pp);
            {
                LAUNDER(pp);
                unsigned char* ws = pp->ws; const unsigned char* wl = ws + WS_W + (size_t)l * W_LAYER;
                pg8::Gemm g{(const bf16_t*)(ws + WS_H), (const bf16_t*)(wl + W_WIN)}; pg8::StaticOrder S; S.init(MTOK / 256, 8, 1, gridDim.x, opaque_bx());
                EpiMixIn E{ws, pp->out, l};
                pg8::gemm_phase<DM, DM, DM, EpiMixIn, pg8::StaticOrder>(lds, g, S, E);
            }
            GSYNC();
            LAUNDER(pp);
            {
                unsigned char* ws = pp->ws; const unsigned char* wl = ws + WS_W + (size_t)l * W_LAYER;
                const int bx = opaque_bx();
                const int tid_ = opaque_tid(); const int lane = tid_ & 63, wave = __builtin_amdgcn_readfirstlane(tid_ >> 6);
                LAS unsigned* wcnt = (LAS unsigned*)(lds + LDS_BARW + 16);
                if (bx < 64) {
                    {   pg8::Gemm g{(const bf16_t*)(ws + WS_H), (const bf16_t*)(wl + W_WIN)}; pg8::SubsetOrder S{0, 32, 64, bx, 8};
                        EpiMixIn E{ws, pp->out, l};
                        pg8::gemm_phase<DM, DM, DM, EpiMixIn, pg8::SubsetOrder>(lds, g, S, E); }
                    LAUNDER(pp);
                    unsigned* tcnt = (unsigned*)(pp->ws + WS_CTL) + 2048 + 64 * l;
                    asm volatile("s_waitcnt vmcnt(0)" ::: "memory"); __syncthreads();
                    if (tid_ == 0) { __builtin_amdgcn_fence(__ATOMIC_RELEASE, "agent"); asm volatile("s_waitcnt vmcnt(0)" ::: "memory"); (void)xb_add(tcnt, 1u);
                        unsigned sp = 0u; while (xb_ld(tcnt) < 64u) { __builtin_amdgcn_s_sleep(2); if (++sp > (1u << 22)) break; }
                        __builtin_amdgcn_fence(__ATOMIC_ACQUIRE, "agent"); asm volatile("s_waitcnt vmcnt(0)" ::: "memory"); *wcnt = 0u; }
                    __syncthreads();
                    for (;;) {
                        unsigned n = 0; if (lane == 0) n = __hip_atomic_fetch_add(wcnt, 1u, __ATOMIC_RELAXED, __HIP_MEMORY_SCOPE_WORKGROUP); n = __builtin_amdgcn_readfirstlane(n);
                        if (n >= 8u) break;
                        LAUNDER(pp);
                        gmlp_wave_unit(bx * 4 + (int)(n >> 1), (int)(n & 1u), l, pp->ws, pp->gmlp_norm, pp->gmlp_b, lds + wave * 17408, lane);
                    }
                } else if (bx < 96) {
                    {   pg8::Gemm g{(const bf16_t*)(ws + WS_DFTS), (const bf16_t*)(ws + WS_TT) + 2097152}; pg8::SubsetOrder S{64, 4, 16, bx, 0};
                        EpiFourier E{ws, MPR, 1024};
                        pg8::gemm_phase<2048, 2048, 2048, EpiFourier, pg8::SubsetOrder>(lds, g, S, E); }
                    LAUNDER(pp); ws = pp->ws;
                    {   pg8::Gemm g{(const bf16_t*)(ws + WS_DFTP), (const bf16_t*)(ws + WS_TT)}; pg8::SubsetOrder S{80, 1, 16, bx, 0};
                        EpiFourier E{ws, 0, 256};
                        pg8::gemm_phase<512, 512, 512, EpiFourier, pg8::SubsetOrder>(lds, g, S, E); }
                }
                __syncthreads();
                if (tid_ == 0) *wcnt = 0u;
                __syncthreads();
                const int sh = bx < 96 ? 0 : 1, cs0 = bx < 96 ? 0 : bx - 96;
                const int i0 = cs0 * 2048 / 160, i1 = (cs0 + sh) * 2048 / 160;
                for (;;) {
                    if (gridDim.x != 256) break;
                    unsigned n = 0; if (lane == 0) n = __hip_atomic_fetch_add(wcnt, 1u, __ATOMIC_RELAXED, __HIP_MEMORY_SCOPE_WORKGROUP); n = __builtin_amdgcn_readfirstlane(n);
                    const int e0 = (i0 + 1) & ~1, ne = i1 > e0 ? (i1 - e0 + 1) >> 1 : 0, o0 = i0 | 1;
                    const int i = (int)n < ne ? e0 + 2 * (int)n : o0 + 2 * ((int)n - ne);
                    if (i >= i1) break;
                    LAUNDER(pp);
                    attn_wave_unit((i & 1) * 1024 + (i >> 1), l, pp->ws, pp->rpb, lds + wave * 17408, lane);
                }
            }
            GSYNC();
            LAUNDER(pp);
#pragma unroll 1
            for (int rep = 0; rep <= ((PROBE_G & 8) ? 1 : 0); ++rep) {
                LAUNDER(pp);
                unsigned char* ws = pp->ws; const unsigned char* wl = ws + WS_W + (size_t)l * W_LAYER;
                pg8::Gemm g{(const bf16_t*)(ws + WS_O), (const bf16_t*)(wl + W_WOUT)}; pg8::StaticOrder S; S.init(MTOK / 256, DM / 256, 2, gridDim.x, opaque_bx());
                EpiF32 E{ws};
                pg8::gemm_phase<DM, DM, DM / 2, EpiF32, pg8::StaticOrder>(lds, g, S, E);
            }
            GSYNC();
            LAUNDER(pp);
            if (PROBE_NORM) { norm_step(pp, l, 2, true); LAUNDER(pp); }
            norm_step(pp, l, 2);
            GSYNC();
        }
    }
    LAUNDER(pp);
    if (PROBE_NORM) { norm_step(pp, 0, 3, true); LAUNDER(pp); }
    norm_step(pp, 0, 3);
}

extern "C" void kernel_launch(void* const* d_in, const int* in_sizes, int n_in, void* d_out, int out_size, void* d_ws, size_t ws_size, hipStream_t stream) {
    static int grid = 0;
    if (grid == 0) {
        if (n_in != 18 || ws_size < WS_END) { fprintf(stderr, "kernel_launch: need 18 inputs and >= %zu bytes of workspace (got %d, %zu)\n", (size_t)WS_END, n_in, ws_size); grid = -1; return; }
        int dev = 0, cus = 0, per_cu = 0;
        hipGetDevice(&dev); hipDeviceGetAttribute(&cus, hipDeviceAttributeMultiprocessorCount, dev);
        if (hipFuncSetAttribute((const void*)fwd_kernel, hipFuncAttributeMaxDynamicSharedMemorySize, LDS_BYTES) != hipSuccess) { fprintf(stderr, "kernel_launch: hipFuncSetAttribute failed\n"); grid = -1; return; }
        if (hipOccupancyMaxActiveBlocksPerMultiprocessor(&per_cu, (const void*)fwd_kernel, NTHR, LDS_BYTES) != hipSuccess || per_cu < 1) { fprintf(stderr, "kernel_launch: occupancy query failed (%d)\n", per_cu); per_cu = 1; }
        (void)hipGetLastError();
        grid = cus * 1;
        fprintf(stderr, "kernel_launch: grid %d (per_cu %d)\n", grid, per_cu);
    }
    if (grid < 0) return;
    (void)hipMemsetAsync((char*)d_ws + WS_CTL, 0, CTL_BYTES, stream);
    Params p{};
    p.x_prompt = (const float*)d_in[0]; p.x_sample = (const float*)d_in[1]; p.cache_k = (const float*)d_in[2]; p.cache_v = (const float*)d_in[3];
    p.c = (const float*)d_in[4]; p.c_ctx = (const float*)d_in[5]; p.ada_w = (const float*)d_in[6]; p.ada_b = (const float*)d_in[7];
    p.norm_pre = (const float*)d_in[8]; p.norm_post = (const float*)d_in[9]; p.ffn_w_in = (const float*)d_in[10]; p.ffn_w_out = (const float*)d_in[11];
    p.w_in = (const float*)d_in[12]; p.w_out = (const float*)d_in[13]; p.rpb = (const float*)d_in[14]; p.gmlp_norm = (const float*)d_in[15];
    p.gmlp_w = (const float*)d_in[16]; p.gmlp_b = (const float*)d_in[17];
    p.out = (float*)d_out; p.ws = (unsigned char*)d_ws;
    void* args[] = {&p};
    hipError_t e = hipLaunchCooperativeKernel((const void*)fwd_kernel, dim3(grid), dim3(NTHR), args, LDS_BYTES, stream);
    if (e != hipSuccess) fprintf(stderr, "kernel_launch: cooperative launch failed: %s (grid %d)\n", hipGetErrorString(e), grid);
}
```
